# Optimizing an MI355X kernel written in HIP

```python
import jax, jax.numpy as jnp
from jax import lax
import numpy as np

D_MODEL = 1024
BATCH = 4
SEQ = 8192
DEPTH = 1
DEC_BATCH = 16
DEC_SEQ = 16
PAST_LEN = 2048

CHUNK = 64
D_MIX = D_MODEL
GDN_HEADS = 8
GDN_DK = 64
GDN_DV = 64
GDN_QK = GDN_HEADS * GDN_DK
GDN_WIDTH = GDN_HEADS * GDN_DV
GDN_CONV_CH = 2 * GDN_QK + GDN_WIDTH
CONV_W = 4
HG_HEADS = 4
HG_DK = 128
HG_DV = 128
HG_QK = HG_HEADS * HG_DK
HG_WIDTH = HG_HEADS * HG_DV
D_IN = GDN_CONV_CH + GDN_WIDTH + 2 * GDN_HEADS + 2 * HG_QK + 2 * HG_WIDTH
EPS = 1e-6

kernel_name = "hybrid_gdn_hgrn2_stream_step"


def _rmsnorm(x, w):
    xf = x.astype(jnp.float32)
    return xf * lax.rsqrt(jnp.mean(xf * xf, axis=-1, keepdims=True) + EPS) * w.astype(jnp.float32)


def _l2norm(x):
    return x * lax.rsqrt(jnp.sum(x * x, axis=-1, keepdims=True) + EPS)


def _to_chunks(t, c):
    B, L, H, d = t.shape
    return t.reshape(B, L // c, c, H, d).transpose(1, 0, 3, 2, 4)


def _from_chunks(t):
    n, B, H, c, d = t.shape
    return t.transpose(1, 0, 3, 2, 4).reshape(B, n * c, H, d)


def _causal_conv(u, buf, w):
    full = jnp.concatenate([buf.astype(jnp.float32), u], axis=1)
    L = u.shape[1]
    wf = w.astype(jnp.float32)
    out = full[:, 0:L] * wf[0]
    for j in range(1, CONV_W):
        out = out + full[:, j:j + L] * wf[j]
    return jax.nn.silu(out), full[:, full.shape[1] - (CONV_W - 1):]


def _gated_delta(q, k, v, g, beta, S0, c):
    dv = v.shape[-1]
    qc, kc, vc = _to_chunks(q, c), _to_chunks(k, c), _to_chunks(v, c)
    gc = _to_chunks(g[..., None], c)[..., 0]
    bc = _to_chunks(beta[..., None], c)[..., 0]
    idx = jnp.arange(c)
    causal = idx[:, None] >= idx[None, :]
    strict = idx[:, None] > idx[None, :]
    eye = jnp.eye(c, dtype=jnp.float32)

    def step(S, inp):
        qi, ki, vi, gi, bi = inp
        gcum = jnp.cumsum(gi, axis=-1)
        diff = gcum[..., :, None] - gcum[..., None, :]
        decay = jnp.where(causal, jnp.exp(jnp.where(causal, diff, 0.0)), 0.0)
        kb = ki * bi[..., None]
        lower = jnp.where(strict, jnp.einsum("bhid,bhjd->bhij", kb, ki) * decay, 0.0)
        rhs = jnp.concatenate([vi * bi[..., None], kb * jnp.exp(gcum)[..., None]], axis=-1)
        a = jnp.broadcast_to(eye, lower.shape) + lower
        sol = lax.linalg.triangular_solve(a, rhs, left_side=True, lower=True, unit_diagonal=True)
        u, w = sol[..., :dv], sol[..., dv:]
        v_new = u - jnp.einsum("bhid,bhde->bhie", w, S)
        attn = jnp.einsum("bhid,bhjd->bhij", qi, ki) * decay
        o = (jnp.einsum("bhid,bhde->bhie", qi * jnp.exp(gcum)[..., None], S)
             + jnp.einsum("bhij,bhje->bhie", attn, v_new))
        glast = gcum[..., -1]
        S_new = (S * jnp.exp(glast)[..., None, None]
                 + jnp.einsum("bhid,bhie->bhde", ki * jnp.exp(glast[..., None] - gcum)[..., None], v_new))
        return S_new, o

    S_fin, o = lax.scan(step, S0.astype(jnp.float32), (qc, kc, vc, gc, bc))
    return _from_chunks(o), S_fin


def _hgrn2(q, k, v, logf, S0, c):
    qc, kc, vc, fc = _to_chunks(q, c), _to_chunks(k, c), _to_chunks(v, c), _to_chunks(logf, c)
    idx = jnp.arange(c)
    causal = (idx[:, None] >= idx[None, :])[..., None]

    def step(S, inp):
        qi, ki, vi, lfi = inp
        b = jnp.cumsum(lfi, axis=2)
        diff = b[:, :, :, None, :] - b[:, :, None, :, :]
        dec = jnp.where(causal, jnp.exp(jnp.where(causal, diff, 0.0)), 0.0)
        attn = jnp.einsum("bhid,bhijd,bhjd->bhij", qi, dec, ki)
        o = (jnp.einsum("bhid,bhde->bhie", qi * jnp.exp(b), S)
             + jnp.einsum("bhij,bhje->bhie", attn, vi))
        blast = b[:, :, -1]
        S_new = (jnp.exp(blast)[..., None] * S
                 + jnp.einsum("bhid,bhie->bhde", ki * jnp.exp(blast[:, :, None] - b), vi))
        return S_new, o

    S_fin, o = lax.scan(step, S0.astype(jnp.float32), (qc, kc, vc, fc))
    return _from_chunks(o), S_fin


def _layer(x, conv_buf, S_gdn, S_hg, c, lb, norm_w, w_in, conv_w, A_log, dt_bias, gdn_norm_w, hg_norm_w, w_out):
    B, L, _ = x.shape
    h = _rmsnorm(x, norm_w)
    proj = h @ w_in.astype(jnp.float32)
    sizes = [GDN_CONV_CH, GDN_WIDTH, GDN_HEADS, GDN_HEADS, HG_QK, HG_QK, HG_WIDTH, HG_WIDTH]
    offs = np.cumsum(sizes)[:-1].tolist()
    qkv, z_a, b_a, a_a, hq, hf, hi, z_b = jnp.split(proj, offs, axis=-1)
    qkv_c, new_buf = _causal_conv(qkv, conv_buf, conv_w)
    q_a, k_a, v_a = jnp.split(qkv_c, [GDN_QK, 2 * GDN_QK], axis=-1)
    q_a = _l2norm(q_a.reshape(B, L, GDN_HEADS, GDN_DK)) * (GDN_DK ** -0.5)
    k_a = _l2norm(k_a.reshape(B, L, GDN_HEADS, GDN_DK))
    v_a = v_a.reshape(B, L, GDN_HEADS, GDN_DV)
    beta = jax.nn.sigmoid(b_a)
    g = -jnp.exp(A_log.astype(jnp.float32)) * jax.nn.softplus(a_a + dt_bias.astype(jnp.float32))
    o_a, S_gdn_new = _gated_delta(q_a, k_a, v_a, g, beta, S_gdn, c)
    o_a = _rmsnorm(o_a, gdn_norm_w) * jax.nn.silu(z_a.reshape(B, L, GDN_HEADS, GDN_DV))
    f = lb + (1.0 - lb) * jax.nn.sigmoid(hf)
    logf = jnp.log(f).reshape(B, L, HG_HEADS, HG_DK)
    k_b = (1.0 - f).reshape(B, L, HG_HEADS, HG_DK)
    q_b = jax.nn.silu(hq).reshape(B, L, HG_HEADS, HG_DK)
    v_b = hi.reshape(B, L, HG_HEADS, HG_DV)
    o_b, S_hg_new = _hgrn2(q_b, k_b, v_b, logf, S_hg, c)
    o_b = _rmsnorm(o_b, hg_norm_w) * jax.nn.silu(z_b.reshape(B, L, HG_HEADS, HG_DV))
    o = jnp.concatenate([o_a.reshape(B, L, GDN_WIDTH), o_b.reshape(B, L, HG_WIDTH)], axis=-1)
    y = x.astype(jnp.float32) + o @ w_out.astype(jnp.float32)
    return y, new_buf, S_gdn_new, S_hg_new


def setup_inputs(seed: int = 0) -> dict:
    key = jax.random.key(seed)
    ks = jax.random.split(key, 16)
    f32 = jnp.float32
    x_prompt = jax.random.normal(ks[0], (BATCH, SEQ, D_MODEL), f32)
    x_sample = jax.random.normal(ks[1], (DEC_BATCH, DEC_SEQ, D_MODEL), f32)
    state_conv = jax.random.normal(ks[2], (DEPTH, DEC_BATCH, CONV_W - 1, GDN_CONV_CH), f32)
    state_gdn = 0.5 * jax.random.normal(ks[3], (DEPTH, DEC_BATCH, GDN_HEADS, GDN_DK, GDN_DV), f32)
    state_hgrn = jax.random.normal(ks[4], (DEPTH, DEC_BATCH, HG_HEADS, HG_DK, HG_DV), f32)
    norm_w = 1.0 + 0.02 * jax.random.normal(ks[5], (DEPTH, D_MODEL), f32)
    w_in = jax.random.normal(ks[6], (DEPTH, D_MODEL, D_IN), f32) * D_MODEL ** -0.5
    conv_w = jax.random.normal(ks[7], (DEPTH, CONV_W, GDN_CONV_CH), f32) * CONV_W ** -0.5
    gdn_A_log = jnp.log(jax.random.uniform(ks[8], (DEPTH, GDN_HEADS), f32, 1.0, 16.0))
    dt = jnp.exp(jax.random.uniform(ks[9], (DEPTH, GDN_HEADS), f32, float(np.log(1e-3)), float(np.log(1e-1))))
    gdn_dt_bias = dt + jnp.log(-jnp.expm1(-dt))
    gdn_norm_w = 1.0 + 0.02 * jax.random.normal(ks[10], (DEPTH, GDN_DV), f32)
    hgrn_lb_logits = 0.1 * jax.random.normal(ks[11], (DEPTH + 1, HG_QK), f32)
    hgrn_norm_w = 1.0 + 0.02 * jax.random.normal(ks[12], (DEPTH, HG_DV), f32)
    w_out = jax.random.normal(ks[13], (DEPTH, D_MIX, D_MODEL), f32) * D_MIX ** -0.5
    final_norm_w = 1.0 + 0.02 * jax.random.normal(ks[14], (D_MODEL,), f32)
    return {"x_prompt": x_prompt, "x_sample": x_sample, "state_conv": state_conv,
            "state_gdn": state_gdn, "state_hgrn": state_hgrn, "norm_w": norm_w, "w_in": w_in,
            "conv_w": conv_w, "gdn_A_log": gdn_A_log, "gdn_dt_bias": gdn_dt_bias,
            "gdn_norm_w": gdn_norm_w, "hgrn_lb_logits": hgrn_lb_logits, "hgrn_norm_w": hgrn_norm_w,
            "w_out": w_out, "final_norm_w": final_norm_w}


def reference(x_prompt, x_sample, state_conv, state_gdn, state_hgrn, norm_w, w_in, conv_w, gdn_A_log,
              gdn_dt_bias, gdn_norm_w, hgrn_lb_logits, hgrn_norm_w, w_out, final_norm_w):
    f32 = jnp.float32
    lb_all = jnp.cumsum(jax.nn.softmax(hgrn_lb_logits.astype(f32), axis=0), axis=0)
    Bp, Ls = x_prompt.shape[0], x_sample.shape[1]
    hp = x_prompt.astype(f32)
    hs = x_sample.astype(f32)
    pc, pg, ph, sc, sg, sh = [], [], [], [], [], []
    for l in range(DEPTH):
        params = (lb_all[l], norm_w[l], w_in[l], conv_w[l], gdn_A_log[l], gdn_dt_bias[l],
                  gdn_norm_w[l], hgrn_norm_w[l], w_out[l])
        hp, c1, g1, r1 = _layer(hp, jnp.zeros((Bp, CONV_W - 1, GDN_CONV_CH), f32),
                                jnp.zeros((Bp, GDN_HEADS, GDN_DK, GDN_DV), f32),
                                jnp.zeros((Bp, HG_HEADS, HG_DK, HG_DV), f32), CHUNK, *params)
        hs, c2, g2, r2 = _layer(hs, state_conv[l], state_gdn[l], state_hgrn[l], Ls, *params)
        pc.append(c1); pg.append(g1); ph.append(r1)
        sc.append(c2); sg.append(g2); sh.append(r2)
    y_prompt = _rmsnorm(hp, final_norm_w).astype(x_prompt.dtype)
    y_sample = _rmsnorm(hs, final_norm_w).astype(x_sample.dtype)
    new_conv_prompt = jnp.stack(pc).astype(x_prompt.dtype)
    new_gdn_prompt = jnp.stack(pg).astype(x_prompt.dtype)
    new_hgrn_prompt = jnp.stack(ph).astype(x_prompt.dtype)
    new_conv_sample = jnp.stack(sc).astype(state_conv.dtype)
    new_gdn_sample = jnp.stack(sg).astype(state_gdn.dtype)
    new_hgrn_sample = jnp.stack(sh).astype(state_hgrn.dtype)
    return (y_prompt, y_sample, new_conv_prompt, new_gdn_prompt, new_hgrn_prompt,
            new_conv_sample, new_gdn_sample, new_hgrn_sample)
```

```cpp
#include <hip/hip_runtime.h>
#include <hip/hip_cooperative_groups.h>
#include <cstdio>
namespace cg = cooperative_groups;

typedef unsigned short u16;
typedef unsigned int u32;
using bf16x8 = __attribute__((ext_vector_type(8))) short;
using f32x4 = __attribute__((ext_vector_type(4))) float;
using u32x4 = __attribute__((ext_vector_type(4))) unsigned;
typedef __bf16 bf16x2_t __attribute__((ext_vector_type(2)));
typedef float f32x2_t __attribute__((ext_vector_type(2)));
#define DI __device__ __forceinline__
#define MFMA(a, b, c) __builtin_amdgcn_mfma_f32_16x16x32_bf16((a), (b), (c), 0, 0, 0)

constexpr int T_ALL = 33024, T_P = 32768, DM = 1024, NP = 4096, NWT = 4224;
constexpr int NUNIT = 528;
constexpr int PQ = 0, PK = 512, PV = 1024, PZA = 1536, PHQ = 2048, PHF = 2560, PHI = 3072, PZB = 3584;
constexpr float EPS = 1e-6f;
constexpr long OY = 0, OCP = 33816576, OGP = 33835008, OHP = 33966080, OCS = 34228224, OGS = 34301952, OHS = 34826240;
constexpr size_t WS_P = 0;
constexpr size_t WS_WIN = WS_P + (size_t)T_ALL * NP * 2;
constexpr size_t WS_WOUT = WS_WIN + (size_t)NWT * DM * 2;
constexpr size_t WS_BA = WS_WOUT + (size_t)DM * DM * 2;
constexpr size_t WS_RSS = WS_BA + (size_t)T_ALL * 16 * 4;
constexpr size_t WS_GM = WS_RSS + (size_t)T_ALL * 16 * 4;
constexpr size_t WS_GN = WS_GM + (size_t)NUNIT * 8 * 8192;
constexpr size_t WS_GO = WS_GN + (size_t)NUNIT * 8 * 8192;
constexpr size_t WS_GS = WS_GO + (size_t)NUNIT * 8 * 8192;
constexpr size_t WS_HD = WS_GS + (size_t)NUNIT * 8 * 8192;
constexpr size_t WS_HDEC = WS_HD + (size_t)NUNIT * 4 * 32768;
constexpr size_t WS_END = WS_HDEC + (size_t)NUNIT * 4 * 128 * 4;
constexpr size_t DO_H = 0;
constexpr size_t DO_GQ = 0;
constexpr size_t DO_HQ = DO_GQ + (size_t)NUNIT * 8 * 8192;
constexpr size_t DO_HO = DO_HQ + (size_t)NUNIT * 4 * 16384;

struct Params {
  const float* x_prompt; const float* x_sample; const float* state_conv; const float* state_gdn; const float* state_hgrn;
  const float* norm_w; const float* w_in; const float* conv_w; const float* A_log; const float* dt_bias;
  const float* gdn_norm_w; const float* lb_logits; const float* hg_norm_w; const float* w_out; const float* final_norm_w;
  float* out; char* ws;
};

DI u32 pk2(float a, float b) { f32x2_t v = {a, b}; bf16x2_t r = __builtin_convertvector(v, bf16x2_t); return __builtin_bit_cast(u32, r); }
DI u16 f2b(float a) { return (u16)(pk2(a, 0.f) & 0xffffu); }
DI float b2f(u16 v) { return __uint_as_float(((u32)v) << 16); }
DI float sigmoidf_(float x) { return 1.f / (1.f + __expf(-x)); }
DI float siluf_(float x) { return x / (1.f + __expf(-x)); }
DI const float* xrow(const Params& p, int r) { return r < T_P ? p.x_prompt + (size_t)r * DM : p.x_sample + (size_t)(r - T_P) * DM; }
DI bf16x8 ldfrag(const u16* base, int ld, int row0, int k0, int lane) {
  return *(const bf16x8*)(base + (size_t)(row0 + (lane & 15)) * ld + k0 + 8 * (lane >> 4));
}
DI int opaque_tid() { int t = threadIdx.x; asm volatile("" : "+v"(t)); return t; }
DI f32x4 zero4() { f32x4 z = {0.f, 0.f, 0.f, 0.f}; return z; }

static __device__ __forceinline__ void phase0(const Params& p, char* smem) {
  const int tid = opaque_tid(), lane = tid & 63, w = tid >> 6;
  u16* hbuf = (u16*)((char*)p.out + DO_H);
  u16* wtin = (u16*)(p.ws + WS_WIN);
  u16* wtout = (u16*)(p.ws + WS_WOUT);
  const int NT_RMS = T_ALL / 4, NT_WIN = (NWT / 64) * 16, NT_WOUT = 256;
  for (int task = blockIdx.x; task < NT_RMS + NT_WIN + NT_WOUT; task += gridDim.x) {
    if (task < NT_RMS) {
      int r = task * 4 + w;
      const float* xr = xrow(p, r);
      float4 v[4]; float ss = 0.f;
#pragma unroll
      for (int i = 0; i < 4; ++i) { v[i] = *(const float4*)(xr + i * 256 + lane * 4); ss += v[i].x * v[i].x + v[i].y * v[i].y + v[i].z * v[i].z + v[i].w * v[i].w; }
#pragma unroll
      for (int o = 32; o > 0; o >>= 1) ss += __shfl_xor(ss, o);
      float rs = rsqrtf(ss * (1.f / DM) + EPS);
#pragma unroll
      for (int i = 0; i < 4; ++i) {
        float4 nw = *(const float4*)(p.norm_w + i * 256 + lane * 4);
        uint2 o; o.x = pk2(v[i].x * rs * nw.x, v[i].y * rs * nw.y); o.y = pk2(v[i].z * rs * nw.z, v[i].w * rs * nw.w);
        *(uint2*)(hbuf + (size_t)r * DM + i * 256 + lane * 4) = o;
      }
    } else {
      float* tile = (float*)smem;
      int tt = task - NT_RMS; const float* src; u16* dst; int ldsrc, nt, kt; bool isin = tt < NT_WIN;
      if (isin) { nt = tt / 16; kt = tt % 16; src = p.w_in; ldsrc = 4112; dst = wtin; }
      else { tt -= NT_WIN; nt = tt / 16; kt = tt % 16; src = p.w_out; ldsrc = 1024; dst = wtout; }
      __syncthreads();
      for (int i = tid; i < 4096; i += 256) {
        int kk = i >> 6, nn = i & 63; int np_ = nt * 64 + nn; float val = 0.f;
        if (isin) {
          int orig = np_ < 2048 ? np_ : (np_ < 4096 ? np_ + 16 : (np_ < 4112 ? np_ - 2048 : -1));
          if (orig >= 0) val = src[(size_t)(kt * 64 + kk) * ldsrc + orig];
        } else val = src[(size_t)(kt * 64 + kk) * ldsrc + np_];
        tile[kk * 65 + nn] = val;
      }
      __syncthreads();
      for (int i = tid; i < 4096; i += 256) {
        int nn = i >> 6, kk = i & 63;
        dst[(size_t)(nt * 64 + nn) * DM + kt * 64 + kk] = f2b(tile[kk * 65 + nn]);
      }
    }
  }
}

DI int swz(int row, int ch) { return row * 128 + ((ch ^ ((row >> 1) & 7)) << 4); }

static __device__ __forceinline__ void gemm_tile(const u16* __restrict__ A, int lda, const u16* __restrict__ Bt, int m0, int n0, char* smem, f32x4 (&acc)[4][4]) {
  const int tid = opaque_tid(), lane = tid & 63, w = tid >> 6, wm = w >> 1, wn = w & 1, l16 = lane & 15, q4 = lane >> 4;
#pragma unroll
  for (int i = 0; i < 4; ++i)
#pragma unroll
    for (int j = 0; j < 4; ++j) acc[i][j] = zero4();
  u32x4 ra[4], rb[4];
  const int srow = tid >> 3, sch = tid & 7;
  const u16* ga = A + (size_t)(m0 + srow) * lda + sch * 8;
  const u16* gb = Bt + (size_t)(n0 + srow) * DM + sch * 8;
#pragma unroll
  for (int i = 0; i < 4; ++i) { ra[i] = *(const u32x4*)(ga + (size_t)i * 32 * lda); rb[i] = *(const u32x4*)(gb + (size_t)i * 32 * DM); }
  __syncthreads();
#pragma unroll
  for (int i = 0; i < 4; ++i) { *(u32x4*)(smem + swz(srow + i * 32, sch)) = ra[i]; *(u32x4*)(smem + 16384 + swz(srow + i * 32, sch)) = rb[i]; }
  __syncthreads();
  for (int kt = 0; kt < 16; ++kt) {
    char* sa = smem + (kt & 1) * 32768; char* sb = sa + 16384;
    if (kt < 15) {
#pragma unroll
      for (int i = 0; i < 4; ++i) { ra[i] = *(const u32x4*)(ga + (size_t)i * 32 * lda + (kt + 1) * 64); rb[i] = *(const u32x4*)(gb + (size_t)i * 32 * DM + (kt + 1) * 64); }
    }
#pragma unroll
    for (int ks = 0; ks < 2; ++ks) {
      bf16x8 af[4], bfr[4];
#pragma unroll
      for (int i = 0; i < 4; ++i) {
        af[i] = *(const bf16x8*)(sa + swz(wm * 64 + i * 16 + l16, ks * 4 + q4));
        bfr[i] = *(const bf16x8*)(sb + swz(wn * 64 + i * 16 + l16, ks * 4 + q4));
      }
#pragma unroll
      for (int i = 0; i < 4; ++i)
#pragma unroll
        for (int j = 0; j < 4; ++j) acc[i][j] = MFMA(af[i], bfr[j], acc[i][j]);
    }
    if (kt < 15) {
      char* da = smem + ((kt + 1) & 1) * 32768;
#pragma unroll
      for (int i = 0; i < 4; ++i) { *(u32x4*)(da + swz(srow + i * 32, sch)) = ra[i]; *(u32x4*)(da + 16384 + swz(srow + i * 32, sch)) = rb[i]; }
    }
    __syncthreads();
  }
}

static __device__ __forceinline__ void phase1(const Params& p, char* smem) {
  const int tid = opaque_tid(), lane = tid & 63, w = tid >> 6, wm = w >> 1, wn = w & 1, l16 = lane & 15, q4 = lane >> 4;
  const u16* hbuf = (const u16*)((char*)p.out + DO_H);
  const u16* wtin = (const u16*)(p.ws + WS_WIN);
  u16* P = (u16*)(p.ws + WS_P);
  float* ba = (float*)(p.ws + WS_BA);
  const int G = gridDim.x;
  int x = blockIdx.x & 7, j = blockIdx.x >> 3, nj = (G + 7 - x) / 8;
  int nxcd = G < 8 ? G : 8;
  if (G < 8) { x = blockIdx.x; j = 0; nj = 1; }
  const int NSUP = 33 * 4;
  for (int s = x; s < NSUP; s += nxcd) {
    int sm = s >> 2, sn = s & 3;
    for (int r = j; r < 64; r += nj) {
      int mt = sm * 8 + (r & 7), nt = sn * 8 + (r >> 3);
      if (mt >= 258) continue;
      f32x4 acc[4][4];
      gemm_tile(hbuf, DM, wtin, mt * 128, nt * 128, smem, acc);
#pragma unroll
      for (int mi = 0; mi < 4; ++mi)
#pragma unroll
        for (int ni = 0; ni < 4; ++ni)
#pragma unroll
          for (int i = 0; i < 4; ++i) {
            int row = mt * 128 + wm * 64 + mi * 16 + q4 * 4 + i, col = nt * 128 + wn * 64 + ni * 16 + l16;
            float v = acc[mi][ni][i];
            P[(size_t)row * NP + col] = f2b(v);
            if (col < 1536) {
              if (row < T_P) { int tt = row & 8191; if (tt >= 8189) p.out[OCP + ((size_t)(row >> 13) * 3 + (tt - 8189)) * 1536 + col] = v; }
              else { int rr = row - T_P, tt = rr & 15; if (tt >= 13) p.out[OCS + ((size_t)(rr >> 4) * 3 + (tt - 13)) * 1536 + col] = v; }
            }
          }
    }
  }
  for (int mt = blockIdx.x; mt < 258; mt += G) {
    f32x4 acc[4][4];
    gemm_tile(hbuf, DM, wtin, mt * 128, 32 * 128, smem, acc);
    if (wn == 0) {
#pragma unroll
      for (int mi = 0; mi < 4; ++mi)
#pragma unroll
        for (int i = 0; i < 4; ++i) {
          int row = mt * 128 + wm * 64 + mi * 16 + q4 * 4 + i;
          ba[(size_t)row * 16 + l16] = acc[mi][0][i];
        }
    }
  }
}

static __device__ __forceinline__ void gdn_prep(const Params& p, int unit, int h, char* smem) {
  const int tid = opaque_tid(), lane = tid & 63, w = tid >> 6, l16 = lane & 15, q4 = lane >> 4;
  const u16* P = (const u16*)(p.ws + WS_P);
  const float* ba = (const float*)(p.ws + WS_BA);
  const bool sample = unit >= 512;
  const int t0 = sample ? T_P + (unit - 512) * 16 : unit * 64;
  const int nv = sample ? 16 : 64;
  const int cseq = sample ? 0 : (unit & 127);
  const int slot = unit * 8 + h;
  u16* qb = (u16*)smem;
  u16* kb = qb + 64 * 72;
  u16* vb = kb + 64 * 72;
  u16* wT = vb;
  u16* kdT = vb + 64 * 72;
  u16* uT = kdT + 64 * 72;
  float* lowf = (float*)(uT + 64 * 72);
  u16* attn = (u16*)lowf;
  float* s_gcum = lowf + 64 * 64;
  float* s_beta = s_gcum + 64;
  float* s_rnk = s_beta + 64;
  float* s_rnq = s_rnk + 64;

  __syncthreads();
  {
    const int c = lane, tg = w;
#pragma unroll
    for (int s3 = 0; s3 < 3; ++s3) {
      const int col = s3 * 512 + h * 64 + c;
      const float w0 = p.conv_w[col], w1 = p.conv_w[1536 + col], w2 = p.conv_w[3072 + col], w3 = p.conv_w[4608 + col];
      float xm3, xm2, xm1;
      {
        float hv[3];
#pragma unroll
        for (int jj = 0; jj < 3; ++jj) {
          int tt = tg * 16 - 3 + jj; float v = 0.f;
          if (tt >= 0) { if (tt < nv) v = b2f(P[(size_t)(t0 + tt) * NP + col]); }
          else if (sample) v = p.state_conv[((size_t)(unit - 512) * 3 + (3 + tt)) * 1536 + col];
          else if (cseq > 0) v = b2f(P[(size_t)(t0 + tt) * NP + col]);
          hv[jj] = v;
        }
        xm3 = hv[0]; xm2 = hv[1]; xm1 = hv[2];
      }
      u16* dstb = s3 == 0 ? qb : (s3 == 1 ? kb : vb);
#pragma unroll
      for (int i = 0; i < 16; ++i) {
        int tt = tg * 16 + i;
        float x0 = tt < nv ? b2f(P[(size_t)(t0 + tt) * NP + col]) : 0.f;
        float o = w0 * xm3 + w1 * xm2 + w2 * xm1 + w3 * x0;
        o = tt < nv ? siluf_(o) : 0.f;
        dstb[tt * 72 + c] = f2b(o);
        xm3 = xm2; xm2 = xm1; xm1 = x0;
      }
    }
    if (tid < 64) {
      int tt = tid; float g = 0.f, be = 0.f;
      if (tt < nv) {
        float bv = ba[(size_t)(t0 + tt) * 16 + h], av = ba[(size_t)(t0 + tt) * 16 + 8 + h];
        be = sigmoidf_(bv);
        float xx = av + p.dt_bias[h];
        float sp = fmaxf(xx, 0.f) + log1pf(__expf(-fabsf(xx)));
        g = -__expf(p.A_log[h]) * sp;
      }
#pragma unroll
      for (int o = 1; o < 64; o <<= 1) { float t = __shfl_up(g, o); if (lane >= o) g += t; }
      s_gcum[tt] = g; s_beta[tt] = be;
    }
  }
  __syncthreads();
  f32x4 kk[4];
  {
    f32x4 qq = zero4();
#pragma unroll
    for (int ni = 0; ni < 4; ++ni) kk[ni] = zero4();
#pragma unroll
    for (int s = 0; s < 2; ++s) {
      bf16x8 a = ldfrag(kb, 72, 16 * w, 32 * s, lane);
#pragma unroll
      for (int ni = 0; ni < 4; ++ni) { bf16x8 b = ldfrag(kb, 72, 16 * ni, 32 * s, lane); kk[ni] = MFMA(a, b, kk[ni]); }
      bf16x8 aq = ldfrag(qb, 72, 16 * w, 32 * s, lane);
      qq = MFMA(aq, aq, qq);
    }
    if (q4 == (l16 >> 2)) {
      int ii = l16 & 3;
      f32x4 kd = w == 0 ? kk[0] : (w == 1 ? kk[1] : (w == 2 ? kk[2] : kk[3]));
      float dk_ = ii == 0 ? kd[0] : (ii == 1 ? kd[1] : (ii == 2 ? kd[2] : kd[3]));
      float dq_ = ii == 0 ? qq[0] : (ii == 1 ? qq[1] : (ii == 2 ? qq[2] : qq[3]));
      s_rnk[16 * w + l16] = rsqrtf(dk_ + EPS);
      s_rnq[16 * w + l16] = rsqrtf(dq_ + EPS) * 0.125f;
    }
  }
  __syncthreads();
  const float glast = s_gcum[63];
#pragma unroll
  for (int ni = 0; ni < 4; ++ni)
#pragma unroll
    for (int i = 0; i < 4; ++i) {
      int row = 16 * w + 4 * q4 + i, col = 16 * ni + l16;
      float v = 0.f;
      if (row > col) v = s_beta[row] * s_rnk[row] * s_rnk[col] * kk[ni][i] * __expf(s_gcum[row] - s_gcum[col]);
      lowf[row * 64 + col] = v;
    }
  {
    const int d = lane, tg = w;
    u32 pk[8];
#pragma unroll
    for (int i = 0; i < 16; i += 2) {
      int ta = tg * 16 + i, tb = ta + 1;
      float va = b2f(kb[ta * 72 + d]) * s_rnk[ta] * __expf(glast - s_gcum[ta]);
      float vb_ = b2f(kb[tb * 72 + d]) * s_rnk[tb] * __expf(glast - s_gcum[tb]);
      pk[i >> 1] = pk2(va, vb_);
    }
    uint4* dst = (uint4*)(kdT + d * 72 + tg * 16);
    dst[0] = make_uint4(pk[0], pk[1], pk[2], pk[3]); dst[1] = make_uint4(pk[4], pk[5], pk[6], pk[7]);
  }
  float X[64];
  if (tid < 128) {
    if (tid < 64) {
#pragma unroll
      for (int i = 0; i < 64; ++i) { X[i] = b2f(vb[i * 72 + tid]) * s_beta[i]; }
    } else {
#pragma unroll
      for (int i = 0; i < 64; ++i) { X[i] = b2f(kb[i * 72 + tid - 64]) * s_rnk[i] * s_beta[i] * __expf(s_gcum[i]); }
    }
  }
  __syncthreads();
  if (tid < 128) {
#pragma unroll
    for (int i = 1; i < 64; ++i) {
      float a = X[i];
#pragma unroll
      for (int j4 = 0; j4 < (i + 3) / 4; ++j4) {
        float4 l = *(const float4*)(lowf + i * 64 + j4 * 4);
        a -= l.x * X[j4 * 4]; a -= l.y * X[j4 * 4 + 1]; a -= l.z * X[j4 * 4 + 2]; a -= l.w * X[j4 * 4 + 3];
      }
      X[i] = a;
    }
    u16* dstT = tid < 64 ? (uT + tid * 72) : (wT + (tid - 64) * 72);
#pragma unroll
    for (int i = 0; i < 64; i += 8) {
      *(uint4*)(dstT + i) = make_uint4(pk2(X[i], X[i + 1]), pk2(X[i + 2], X[i + 3]), pk2(X[i + 4], X[i + 5]), pk2(X[i + 6], X[i + 7]));
    }
  }
  __syncthreads();
  {
    f32x4 qk[4];
#pragma unroll
    for (int ni = 0; ni < 4; ++ni) qk[ni] = zero4();
#pragma unroll
    for (int s = 0; s < 2; ++s) {
      bf16x8 a = ldfrag(qb, 72, 16 * w, 32 * s, lane);
#pragma unroll
      for (int ni = 0; ni < 4; ++ni) { bf16x8 b = ldfrag(kb, 72, 16 * ni, 32 * s, lane); qk[ni] = MFMA(a, b, qk[ni]); }
    }
#pragma unroll
    for (int ni = 0; ni < 4; ++ni)
#pragma unroll
      for (int i = 0; i < 4; ++i) {
        int row = 16 * w + 4 * q4 + i, col = 16 * ni + l16;
        float v = 0.f;
        if (row >= col) v = qk[ni][i] * s_rnq[row] * s_rnk[col] * __expf(s_gcum[row] - s_gcum[col]);
        attn[row * 72 + col] = f2b(v);
      }
  }
  __syncthreads();
  {
    u16* gM = (u16*)(p.ws + WS_GM) + (size_t)slot * 4096;
    u16* gN = (u16*)(p.ws + WS_GN) + (size_t)slot * 4096;
    u16* gO = (u16*)(p.ws + WS_GO) + (size_t)slot * 4096;
    u16* gQ = (u16*)((char*)p.out + DO_GQ) + (size_t)slot * 4096;
    f32x4 aM[4], aN[4], aW[4], aU[4];
#pragma unroll
    for (int ni = 0; ni < 4; ++ni) { aM[ni] = zero4(); aN[ni] = zero4(); aW[ni] = zero4(); aU[ni] = zero4(); }
#pragma unroll
    for (int s = 0; s < 2; ++s) {
      bf16x8 akd = ldfrag(kdT, 72, 16 * w, 32 * s, lane);
      bf16x8 aat = ldfrag(attn, 72, 16 * w, 32 * s, lane);
#pragma unroll
      for (int ni = 0; ni < 4; ++ni) {
        bf16x8 bw = ldfrag(wT, 72, 16 * ni, 32 * s, lane);
        bf16x8 bu = ldfrag(uT, 72, 16 * ni, 32 * s, lane);
        aM[ni] = MFMA(akd, bw, aM[ni]); aN[ni] = MFMA(akd, bu, aN[ni]);
        aW[ni] = MFMA(aat, bw, aW[ni]); aU[ni] = MFMA(aat, bu, aU[ni]);
      }
    }
    const float eg = __expf(glast);
#pragma unroll
    for (int ni = 0; ni < 4; ++ni) {
#pragma unroll
      for (int i = 0; i < 4; ++i) {
        int row = 16 * w + 4 * q4 + i, col = 16 * ni + l16;
        gM[row * 64 + col] = f2b((row == col ? eg : 0.f) - aM[ni][i]);
        float qv = b2f(qb[row * 72 + col]) * s_rnq[row] * __expf(s_gcum[row]);
        gQ[row * 64 + col] = f2b(qv - aW[ni][i]);
      }
      *(uint2*)(gN + ((ni * 4 + w) * 64 + lane) * 4) = make_uint2(pk2(aN[ni][0], aN[ni][1]), pk2(aN[ni][2], aN[ni][3]));
      *(uint2*)(gO + ((w * 4 + ni) * 64 + lane) * 4) = make_uint2(pk2(aU[ni][0], aU[ni][1]), pk2(aU[ni][2], aU[ni][3]));
    }
  }
}

static __device__ __forceinline__ void hg_prep(const Params& p, int unit, int h, char* smem) {
  const int tid = opaque_tid(), lane = tid & 63, w = tid >> 6, l16 = lane & 15, q4 = lane >> 4;
  const u16* P = (const u16*)(p.ws + WS_P);
  const bool sample = unit >= 512;
  const int t0 = sample ? T_P + (unit - 512) * 16 : unit * 64;
  const int nv = sample ? 16 : 64;
  const int slot = unit * 4 + h;
  u16* qt = (u16*)smem;
  u16* kt = qt + 64 * 136;
  u16* vT = kt + 64 * 136;
  u16* kdT = (u16*)smem;
  u16* attn = kdT + 128 * 72;
  float lf[64]; float blast = 0.f;
  __syncthreads();
  if (tid < 128) {
    const int d = tid, dg = h * 128 + d;
    const float lb = sigmoidf_(p.lb_logits[dg] - p.lb_logits[512 + dg]);
#pragma unroll
    for (int t = 0; t < 64; ++t) {
      float v = 0.f;
      if (t < nv) { float xx = b2f(P[(size_t)(t0 + t) * NP + PHF + dg]); float f = lb + (1.f - lb) * sigmoidf_(xx); v = __logf(f); }
      lf[t] = v;
    }
    float b = 0.f;
#pragma unroll
    for (int t = 0; t < 64; ++t) {
      b += lf[t];
      float eb = __expf(b);
      float qv = 0.f;
      if (t < nv) qv = siluf_(b2f(P[(size_t)(t0 + t) * NP + PHQ + dg])) * eb;
      float kv = (1.f - __expf(lf[t])) / eb;
      qt[t * 136 + d] = f2b(qv); kt[t * 136 + d] = f2b(kv);
    }
    blast = b;
    ((float*)(p.ws + WS_HDEC))[(size_t)slot * 128 + d] = __expf(blast);
  } else {
    const int e = tid - 128, eg = h * 128 + e;
    u16* dst = vT + e * 72;
#pragma unroll
    for (int t = 0; t < 64; t += 2) {
      u16 a = t < nv ? P[(size_t)(t0 + t) * NP + PHI + eg] : (u16)0;
      u16 b = (t + 1) < nv ? P[(size_t)(t0 + t + 1) * NP + PHI + eg] : (u16)0;
      *(u32*)(dst + t) = (u32)a | ((u32)b << 16);
    }
  }
  __syncthreads();
  f32x4 at[4];
#pragma unroll
  for (int ni = 0; ni < 4; ++ni) at[ni] = zero4();
#pragma unroll
  for (int s = 0; s < 4; ++s) {
    bf16x8 a = ldfrag(qt, 136, 16 * w, 32 * s, lane);
#pragma unroll
    for (int ni = 0; ni < 4; ++ni) { bf16x8 b = ldfrag(kt, 136, 16 * ni, 32 * s, lane); at[ni] = MFMA(a, b, at[ni]); }
  }
  {
    u16* gq = (u16*)((char*)p.out + DO_HQ) + (size_t)slot * 8192;
#pragma unroll
    for (int k = 0; k < 4; ++k) {
      int id = tid + 256 * k, row = id >> 4, cc = id & 15;
      *(uint4*)(gq + row * 128 + cc * 8) = *(const uint4*)(qt + row * 136 + cc * 8);
    }
  }
  __syncthreads();
  if (tid < 128) {
    const int d = tid;
    float b = 0.f;
#pragma unroll
    for (int t = 0; t < 64; t += 8) {
      float kv[8];
#pragma unroll
      for (int k = 0; k < 8; ++k) { b += lf[t + k]; kv[k] = (1.f - __expf(lf[t + k])) * __expf(blast - b); }
      *(uint4*)(kdT + d * 72 + t) = make_uint4(pk2(kv[0], kv[1]), pk2(kv[2], kv[3]), pk2(kv[4], kv[5]), pk2(kv[6], kv[7]));
    }
  }
#pragma unroll
  for (int ni = 0; ni < 4; ++ni)
#pragma unroll
    for (int i = 0; i < 4; ++i) {
      int row = 16 * w + 4 * q4 + i, col = 16 * ni + l16;
      attn[row * 72 + col] = f2b(row >= col ? at[ni][i] : 0.f);
    }
  __syncthreads();
  {
    u16* hD = (u16*)(p.ws + WS_HD) + (size_t)slot * 16384;
    u16* gOh = (u16*)((char*)p.out + DO_HO) + (size_t)slot * 8192;
#pragma unroll
    for (int mi = 0; mi < 2; ++mi) {
      f32x4 acc[8];
#pragma unroll
      for (int ni = 0; ni < 8; ++ni) acc[ni] = zero4();
#pragma unroll
      for (int s = 0; s < 2; ++s) {
        bf16x8 a = ldfrag(vT, 72, 32 * w + 16 * mi, 32 * s, lane);
#pragma unroll
        for (int ni = 0; ni < 8; ++ni) { bf16x8 b = ldfrag(kdT, 72, 16 * ni, 32 * s, lane); acc[ni] = MFMA(a, b, acc[ni]); }
      }
#pragma unroll
      for (int ni = 0; ni < 8; ++ni)
#pragma unroll
        for (int i = 0; i < 4; ++i) {
          int e = 32 * w + 16 * mi + 4 * q4 + i, d = 16 * ni + l16;
          hD[e * 128 + d] = f2b(acc[ni][i]);
        }
    }
    f32x4 ao[8];
#pragma unroll
    for (int ni = 0; ni < 8; ++ni) ao[ni] = zero4();
#pragma unroll
    for (int s = 0; s < 2; ++s) {
      bf16x8 a = ldfrag(attn, 72, 16 * w, 32 * s, lane);
#pragma unroll
      for (int ni = 0; ni < 8; ++ni) { bf16x8 b = ldfrag(vT, 72, 16 * ni, 32 * s, lane); ao[ni] = MFMA(a, b, ao[ni]); }
    }
#pragma unroll
    for (int ni = 0; ni < 8; ++ni)
      *(uint2*)(gOh + ((w * 8 + ni) * 64 + lane) * 4) = make_uint2(pk2(ao[ni][0], ao[ni][1]), pk2(ao[ni][2], ao[ni][3]));
  }
}

static __device__ __forceinline__ void phase2a(const Params& p, char* smem) {
  for (int it = blockIdx.x; it < NUNIT * 8; it += gridDim.x) gdn_prep(p, it >> 3, it & 7, smem);
}
static __device__ __forceinline__ void phase2b(const Params& p, char* smem) {
  for (int it = blockIdx.x; it < NUNIT * 4; it += gridDim.x) hg_prep(p, it >> 2, it & 3, smem);
}

struct GStage { uint2 a[4][2][2]; uint2 n[4]; };

DI void gdn_load(GStage& st, const u16* gM, const u16* gN, int slot, int slice, int lane) {
  const int l16 = lane & 15, q4 = lane >> 4;
  const u16* m = gM + (size_t)slot * 4096;
  const u16* n = gN + (size_t)slot * 4096;
#pragma unroll
  for (int r = 0; r < 4; ++r) {
#pragma unroll
    for (int s = 0; s < 2; ++s) {
      st.a[r][s][0] = *(const uint2*)(m + (16 * r + l16) * 64 + 32 * s + 4 * q4);
      st.a[r][s][1] = *(const uint2*)(m + (16 * r + l16) * 64 + 32 * s + 16 + 4 * q4);
    }
    st.n[r] = *(const uint2*)(n + ((slice * 4 + r) * 64 + lane) * 4);
  }
}

DI void gdn_step(f32x4 (&S)[4], const GStage& st, u16* gS, int slot, int slice, int lane) {
  const int l16 = lane & 15, q4 = lane >> 4;
  u32 sp[4][2];
#pragma unroll
  for (int r = 0; r < 4; ++r) { sp[r][0] = pk2(S[r][0], S[r][1]); sp[r][1] = pk2(S[r][2], S[r][3]); }
  u16* dst = gS + (size_t)slot * 4096 + (slice * 16 + l16) * 64 + 4 * q4;
#pragma unroll
  for (int r = 0; r < 4; ++r) *(uint2*)(dst + 16 * r) = make_uint2(sp[r][0], sp[r][1]);
  bf16x8 b0 = __builtin_bit_cast(bf16x8, make_uint4(sp[0][0], sp[0][1], sp[1][0], sp[1][1]));
  bf16x8 b1 = __builtin_bit_cast(bf16x8, make_uint4(sp[2][0], sp[2][1], sp[3][0], sp[3][1]));
#pragma unroll
  for (int r = 0; r < 4; ++r) {
    f32x4 acc;
    acc[0] = __uint_as_float(st.n[r].x << 16); acc[1] = __uint_as_float(st.n[r].x & 0xffff0000u);
    acc[2] = __uint_as_float(st.n[r].y << 16); acc[3] = __uint_as_float(st.n[r].y & 0xffff0000u);
    bf16x8 a0 = __builtin_bit_cast(bf16x8, make_uint4(st.a[r][0][0].x, st.a[r][0][0].y, st.a[r][0][1].x, st.a[r][0][1].y));
    bf16x8 a1 = __builtin_bit_cast(bf16x8, make_uint4(st.a[r][1][0].x, st.a[r][1][0].y, st.a[r][1][1].x, st.a[r][1][1].y));
    acc = MFMA(a0, b0, acc);
    acc = MFMA(a1, b1, acc);
    S[r] = acc;
  }
}

static __device__ __forceinline__ void gdn_scan_task(const Params& p, int task, int lane) {
  const int l16 = lane & 15, q4 = lane >> 4;
  const u16* gM = (const u16*)(p.ws + WS_GM);
  const u16* gN = (const u16*)(p.ws + WS_GN);
  u16* gS = (u16*)(p.ws + WS_GS);
  f32x4 S[4];
  if (task < 128) {
    const int b = task >> 5, h = (task >> 2) & 7, slice = task & 3;
#pragma unroll
    for (int r = 0; r < 4; ++r) S[r] = zero4();
    GStage st[3];
#pragma unroll
    for (int k = 0; k < 3; ++k) gdn_load(st[k], gM, gN, (b * 128 + k) * 8 + h, slice, lane);
    for (int c0 = 0; c0 < 129; c0 += 3) {
#pragma unroll
      for (int k = 0; k < 3; ++k) {
        int c = c0 + k;
        if (c < 128) gdn_step(S, st[k], gS, (b * 128 + c) * 8 + h, slice, lane);
        if (c + 3 < 128) gdn_load(st[k], gM, gN, (b * 128 + c + 3) * 8 + h, slice, lane);
      }
    }
    float* o = p.out + OGP + (size_t)(b * 8 + h) * 4096;
#pragma unroll
    for (int r = 0; r < 4; ++r)
#pragma unroll
      for (int i = 0; i < 4; ++i) o[(16 * r + 4 * q4 + i) * 64 + slice * 16 + l16] = S[r][i];
  } else {
    const int k = task - 128; const int b = k >> 5, h = (k >> 2) & 7, slice = k & 3;
    const float* s0 = p.state_gdn + (size_t)(b * 8 + h) * 4096;
#pragma unroll
    for (int r = 0; r < 4; ++r)
#pragma unroll
      for (int i = 0; i < 4; ++i) S[r][i] = s0[(16 * r + 4 * q4 + i) * 64 + slice * 16 + l16];
    GStage st;
    const int slot = (512 + b) * 8 + h;
    gdn_load(st, gM, gN, slot, slice, lane);
    gdn_step(S, st, gS, slot, slice, lane);
    float* o = p.out + OGS + (size_t)(b * 8 + h) * 4096;
#pragma unroll
    for (int r = 0; r < 4; ++r)
#pragma unroll
      for (int i = 0; i < 4; ++i) o[(16 * r + 4 * q4 + i) * 64 + slice * 16 + l16] = S[r][i];
  }
}

DI void hg_elem_step(float (&S)[8], uint4& dl, const float4& d0, const float4& d1, u16* ptr) {
  uint4 prev = make_uint4(pk2(S[0], S[1]), pk2(S[2], S[3]), pk2(S[4], S[5]), pk2(S[6], S[7]));
  *(uint4*)ptr = prev;
  S[0] = d0.x * S[0] + __uint_as_float(dl.x << 16); S[1] = d0.y * S[1] + __uint_as_float(dl.x & 0xffff0000u);
  S[2] = d0.z * S[2] + __uint_as_float(dl.y << 16); S[3] = d0.w * S[3] + __uint_as_float(dl.y & 0xffff0000u);
  S[4] = d1.x * S[4] + __uint_as_float(dl.z << 16); S[5] = d1.y * S[5] + __uint_as_float(dl.z & 0xffff0000u);
  S[6] = d1.z * S[6] + __uint_as_float(dl.w << 16); S[7] = d1.w * S[7] + __uint_as_float(dl.w & 0xffff0000u);
}

static __device__ __forceinline__ void hg_scan_task(const Params& p, int task, int lane) {
  u16* hD = (u16*)(p.ws + WS_HD);
  const float* hdec = (const float*)(p.ws + WS_HDEC);
  float S[8];
  if (task < 512) {
    const int bh = task >> 5, b = bh >> 2, h = bh & 3;
    const int el8 = ((task & 31) << 6) + lane, e = el8 >> 4, d0 = (el8 & 15) * 8;
#pragma unroll
    for (int k = 0; k < 8; ++k) S[k] = 0.f;
    for (int c0 = 0; c0 < 128; c0 += 8) {
      uint4 dl[8]; float4 da[8], db[8];
#pragma unroll
      for (int k = 0; k < 8; ++k) {
        size_t slot = (size_t)(b * 128 + c0 + k) * 4 + h;
        dl[k] = *(const uint4*)(hD + slot * 16384 + el8 * 8);
        da[k] = *(const float4*)(hdec + slot * 128 + d0); db[k] = *(const float4*)(hdec + slot * 128 + d0 + 4);
      }
#pragma unroll
      for (int k = 0; k < 8; ++k) {
        size_t slot = (size_t)(b * 128 + c0 + k) * 4 + h;
        hg_elem_step(S, dl[k], da[k], db[k], hD + slot * 16384 + el8 * 8);
      }
    }
    float* o = p.out + OHP + (size_t)bh * 16384;
#pragma unroll
    for (int k = 0; k < 8; ++k) o[(d0 + k) * 128 + e] = S[k];
  } else {
    const int k2 = task - 512; const int bh = k2 >> 5, b = bh >> 2, h = bh & 3;
    const int el8 = ((k2 & 31) << 6) + lane, e = el8 >> 4, d0 = (el8 & 15) * 8;
    const float* s0 = p.state_hgrn + (size_t)bh * 16384;
#pragma unroll
    for (int k = 0; k < 8; ++k) S[k] = s0[(d0 + k) * 128 + e];
    size_t slot = (size_t)(512 + b) * 4 + h;
    uint4 dl = *(const uint4*)(hD + slot * 16384 + el8 * 8);
    float4 da = *(const float4*)(hdec + slot * 128 + d0), db = *(const float4*)(hdec + slot * 128 + d0 + 4);
    hg_elem_step(S, dl, da, db, hD + slot * 16384 + el8 * 8);
    float* o = p.out + OHS + (size_t)bh * 16384;
#pragma unroll
    for (int k = 0; k < 8; ++k) o[(d0 + k) * 128 + e] = S[k];
  }
}

static __device__ __forceinline__ void phase3(const Params& p) {
  const int tid3 = opaque_tid(); const int lane = tid3 & 63, w = tid3 >> 6;
  const int GW = gridDim.x * 4;
  const int NGT = 128 + 512, NHT = 512 + 2048;
  for (int task = w * gridDim.x + blockIdx.x; task < NGT + NHT; task += GW) {
    if (task < NGT) gdn_scan_task(p, task, lane);
    else hg_scan_task(p, task - NGT, lane);
  }
}

static __device__ __forceinline__ void phase4(const Params& p) {
  const int tid = opaque_tid(), lane = tid & 63, w = tid >> 6, l16 = lane & 15, q4 = lane >> 4;
  u16* P = (u16*)(p.ws + WS_P);
  for (int it = blockIdx.x; it < NUNIT * 12; it += gridDim.x) {
    const int unit = it / 12, hh = it % 12;
    const bool sample = unit >= 512;
    const int t0 = sample ? T_P + (unit - 512) * 16 : unit * 64;
    if (sample && w > 0) continue;
    if (hh < 8) {
      const int slot = unit * 8 + hh;
      const u16* gQ = (const u16*)((char*)p.out + DO_GQ) + (size_t)slot * 4096;
      const u16* gS = (const u16*)(p.ws + WS_GS) + (size_t)slot * 4096;
      const u16* gO = (const u16*)(p.ws + WS_GO) + (size_t)slot * 4096;
      f32x4 acc[4];
#pragma unroll
      for (int ni = 0; ni < 4; ++ni) {
        uint2 ov = *(const uint2*)(gO + ((w * 4 + ni) * 64 + lane) * 4);
        acc[ni][0] = __uint_as_float(ov.x << 16); acc[ni][1] = __uint_as_float(ov.x & 0xffff0000u);
        acc[ni][2] = __uint_as_float(ov.y << 16); acc[ni][3] = __uint_as_float(ov.y & 0xffff0000u);
      }
#pragma unroll
      for (int s = 0; s < 2; ++s) {
        bf16x8 a = ldfrag(gQ, 64, 16 * w, 32 * s, lane);
#pragma unroll
        for (int ni = 0; ni < 4; ++ni) { bf16x8 b = ldfrag(gS, 64, 16 * ni, 32 * s, lane); acc[ni] = MFMA(a, b, acc[ni]); }
      }
      float ss[4];
#pragma unroll
      for (int i = 0; i < 4; ++i) {
        float s_ = 0.f;
#pragma unroll
        for (int ni = 0; ni < 4; ++ni) s_ += acc[ni][i] * acc[ni][i];
        s_ += __shfl_xor(s_, 1); s_ += __shfl_xor(s_, 2); s_ += __shfl_xor(s_, 4); s_ += __shfl_xor(s_, 8);
        ss[i] = rsqrtf(s_ * (1.f / 64.f) + EPS);
      }
#pragma unroll
      for (int ni = 0; ni < 4; ++ni) {
        const int e = 16 * ni + l16; const float nw = p.gdn_norm_w[e];
#pragma unroll
        for (int i = 0; i < 4; ++i) {
          int tok = t0 + 16 * w + 4 * q4 + i;
          float z = b2f(P[(size_t)tok * NP + PZA + hh * 64 + e]);
          P[(size_t)tok * NP + hh * 64 + e] = f2b(acc[ni][i] * ss[i] * nw * siluf_(z));
        }
      }
    } else {
      const int h = hh - 8, slot = unit * 4 + h;
      const u16* gq = (const u16*)((char*)p.out + DO_HQ) + (size_t)slot * 8192;
      const u16* gOh = (const u16*)((char*)p.out + DO_HO) + (size_t)slot * 8192;
      const u16* hS = (const u16*)(p.ws + WS_HD) + (size_t)slot * 16384;
      f32x4 acc[8];
#pragma unroll
      for (int ni = 0; ni < 8; ++ni) {
        uint2 ov = *(const uint2*)(gOh + ((w * 8 + ni) * 64 + lane) * 4);
        acc[ni][0] = __uint_as_float(ov.x << 16); acc[ni][1] = __uint_as_float(ov.x & 0xffff0000u);
        acc[ni][2] = __uint_as_float(ov.y << 16); acc[ni][3] = __uint_as_float(ov.y & 0xffff0000u);
      }
#pragma unroll
      for (int s = 0; s < 4; ++s) {
        bf16x8 a = ldfrag(gq, 128, 16 * w, 32 * s, lane);
#pragma unroll
        for (int ni = 0; ni < 8; ++ni) { bf16x8 b = ldfrag(hS, 128, 16 * ni, 32 * s, lane); acc[ni] = MFMA(a, b, acc[ni]); }
      }
      float ss[4];
#pragma unroll
      for (int i = 0; i < 4; ++i) {
        float s_ = 0.f;
#pragma unroll
        for (int ni = 0; ni < 8; ++ni) s_ += acc[ni][i] * acc[ni][i];
        s_ += __shfl_xor(s_, 1); s_ += __shfl_xor(s_, 2); s_ += __shfl_xor(s_, 4); s_ += __shfl_xor(s_, 8);
        ss[i] = rsqrtf(s_ * (1.f / 128.f) + EPS);
      }
#pragma unroll
      for (int ni = 0; ni < 8; ++ni) {
        const int e = 16 * ni + l16; const float nw = p.hg_norm_w[e];
#pragma unroll
        for (int i = 0; i < 4; ++i) {
          int tok = t0 + 16 * w + 4 * q4 + i;
          float z = b2f(P[(size_t)tok * NP + PZB + h * 128 + e]);
          P[(size_t)tok * NP + 512 + h * 128 + e] = f2b(acc[ni][i] * ss[i] * nw * siluf_(z));
        }
      }
    }
  }
}

static __device__ __forceinline__ void phase5(const Params& p, char* smem) {
  const int tid = opaque_tid(), lane = tid & 63, w = tid >> 6, wm = w >> 1, wn = w & 1, l16 = lane & 15, q4 = lane >> 4;
  const u16* obuf = (const u16*)(p.ws + WS_P);
  const u16* wtout = (const u16*)(p.ws + WS_WOUT);
  float* rss = (float*)(p.ws + WS_RSS);
  const int G = gridDim.x;
  int x = blockIdx.x & 7, j = blockIdx.x >> 3, nj = (G + 7 - x) / 8, nxcd = 8;
  if (G < 8) { x = blockIdx.x; j = 0; nj = 1; nxcd = G; }
  const int nmt = (258 - x + nxcd - 1) / nxcd;
  for (int li = j; li < nmt * 8; li += nj) {
    const int mt = x + (li >> 3) * nxcd, nt = li & 7;
    f32x4 acc[4][4];
    gemm_tile(obuf, NP, wtout, mt * 128, nt * 128, smem, acc);
#pragma unroll
    for (int mi = 0; mi < 4; ++mi)
#pragma unroll
      for (int i = 0; i < 4; ++i) {
        const int row = mt * 128 + wm * 64 + mi * 16 + q4 * 4 + i;
        const float* xr = xrow(p, row);
        float s_ = 0.f;
#pragma unroll
        for (int ni = 0; ni < 4; ++ni) {
          const int col = nt * 128 + wn * 64 + ni * 16 + l16;
          float y = acc[mi][ni][i] + xr[col];
          p.out[OY + (size_t)row * DM + col] = y;
          s_ += y * y;
        }
        s_ += __shfl_xor(s_, 1); s_ += __shfl_xor(s_, 2); s_ += __shfl_xor(s_, 4); s_ += __shfl_xor(s_, 8);
        if (l16 == 0) rss[(size_t)row * 16 + nt * 2 + wn] = s_;
      }
  }
}

static __device__ __forceinline__ void phase6(const Params& p) {
  const int tid = opaque_tid(), lane = tid & 63, w = tid >> 6;
  const float* rss = (const float*)(p.ws + WS_RSS);
  for (int task = blockIdx.x; task < T_ALL / 4; task += gridDim.x) {
    const int r = task * 4 + w;
    float s_ = lane < 16 ? rss[(size_t)r * 16 + lane] : 0.f;
    s_ += __shfl_xor(s_, 1); s_ += __shfl_xor(s_, 2); s_ += __shfl_xor(s_, 4); s_ += __shfl_xor(s_, 8);
    s_ = __shfl(s_, 0);
    const float rs = rsqrtf(s_ * (1.f / DM) + EPS);
    float* yr = p.out + OY + (size_t)r * DM;
#pragma unroll
    for (int i = 0; i < 4; ++i) {
      float4 v = *(float4*)(yr + i * 256 + lane * 4);
      float4 nw = *(const float4*)(p.final_norm_w + i * 256 + lane * 4);
      v.x *= rs * nw.x; v.y *= rs * nw.y; v.z *= rs * nw.z; v.w *= rs * nw.w;
      *(float4*)(yr + i * 256 + lane * 4) = v;
    }
  }
}

__global__ void __launch_bounds__(256, 2) fwd_megakernel(Params p) {
  __shared__ __attribute__((aligned(16))) char smem[65536];
  cg::grid_group grid = cg::this_grid();
  phase0(p, smem);
  grid.sync();
  phase1(p, smem);
  grid.sync();
  phase2a(p, smem);
  phase2b(p, smem);
  grid.sync();
  phase3(p);
  grid.sync();
  phase4(p);
  grid.sync();
  phase5(p, smem);
  grid.sync();
  phase6(p);
}

extern "C" void kernel_launch(void* const* d_in, const int* in_sizes, int n_in, void* d_out, int out_size, void* d_ws, size_t ws_size,
                              hipStream_t stream) {
  static int grid_blocks = 0;
  if (!grid_blocks) {
    int dev = 0, cus = 0, per_cu = 0;
    hipGetDevice(&dev);
    hipDeviceGetAttribute(&cus, hipDeviceAttributeMultiprocessorCount, dev);
    hipOccupancyMaxActiveBlocksPerMultiprocessor(&per_cu, fwd_megakernel, 256, 0);
    if (per_cu > 2) per_cu = 2;
    if (per_cu < 1) per_cu = 1;
    grid_blocks = cus * per_cu;
  }
  if (ws_size < WS_END) { fprintf(stderr, "workspace too small\n"); return; }
  Params p{};
  p.x_prompt = (const float*)d_in[0]; p.x_sample = (const float*)d_in[1]; p.state_conv = (const float*)d_in[2];
  p.state_gdn = (const float*)d_in[3]; p.state_hgrn = (const float*)d_in[4]; p.norm_w = (const float*)d_in[5];
  p.w_in = (const float*)d_in[6]; p.conv_w = (const float*)d_in[7]; p.A_log = (const float*)d_in[8]; p.dt_bias = (const float*)d_in[9];
  p.gdn_norm_w = (const float*)d_in[10]; p.lb_logits = (const float*)d_in[11]; p.hg_norm_w = (const float*)d_in[12];
  p.w_out = (const float*)d_in[13]; p.final_norm_w = (const float*)d_in[14];
  p.out = (float*)d_out; p.ws = (char*)d_ws;
  void* args[] = {&p};
  hipError_t e = hipLaunchCooperativeKernel((void*)fwd_megakernel, dim3(grid_blocks), dim3(256), args, 0, stream);
  if (e != hipSuccess) fprintf(stderr, "cooperative launch failed: %s (grid %d)\n", hipGetErrorString(e), grid_blocks);
}
```

```cpp
#include <hip/hip_runtime.h>
#include <hip/hip_cooperative_groups.h>
#include <cstdio>
namespace cg = cooperative_groups;

typedef unsigned short u16;
typedef unsigned int u32;
using bf16x8 = __attribute__((ext_vector_type(8))) short;
using f32x4 = __attribute__((ext_vector_type(4))) float;
using u32x4 = __attribute__((ext_vector_type(4))) unsigned;
typedef __bf16 bf16x2_t __attribute__((ext_vector_type(2)));
typedef float f32x2_t __attribute__((ext_vector_type(2)));
#define DI __device__ __forceinline__
#define MFMA(a, b, c) __builtin_amdgcn_mfma_f32_16x16x32_bf16((a), (b), (c), 0, 0, 0)

constexpr int T_ALL = 33024, T_P = 32768, DM = 1024, NP = 4096, NWT = 4224;
constexpr int NUNIT = 528;
constexpr int PQ = 0, PK = 512, PV = 1024, PZA = 1536, PHQ = 2048, PHF = 2560, PHI = 3072, PZB = 3584;
constexpr float EPS = 1e-6f;
constexpr long OY = 0, OCP = 33816576, OGP = 33835008, OHP = 33966080, OCS = 34228224, OGS = 34301952, OHS = 34826240;
constexpr size_t WS_P = 0;
constexpr size_t WS_WIN = WS_P + (size_t)T_ALL * NP * 2;
constexpr size_t WS_WOUT = WS_WIN + (size_t)NWT * DM * 2;
constexpr size_t WS_BA = WS_WOUT + (size_t)DM * DM * 2;
constexpr size_t WS_RSS = WS_BA + (size_t)T_ALL * 16 * 4;
constexpr size_t WS_GM = WS_RSS + (size_t)T_ALL * 16 * 4;
constexpr size_t WS_GN = WS_GM + (size_t)NUNIT * 8 * 8192;
constexpr size_t WS_GO = WS_GN + (size_t)NUNIT * 8 * 8192;
constexpr size_t WS_GS = WS_GO + (size_t)NUNIT * 8 * 8192;
constexpr size_t WS_HD = WS_GS + (size_t)NUNIT * 8 * 8192;
constexpr size_t WS_HDEC = WS_HD + (size_t)NUNIT * 4 * 32768;
constexpr size_t WS_BAR = WS_HDEC + (size_t)NUNIT * 4 * 128 * 4;
constexpr size_t WS_PART = WS_BAR + 16384;
constexpr size_t WS_END = WS_PART + (size_t)8 * 256 * 1024 * 4;
constexpr size_t DO_H = 0;
constexpr size_t DO_GQ = 0;
constexpr size_t DO_HQ = DO_GQ + (size_t)NUNIT * 8 * 8192;
constexpr size_t DO_HO = DO_HQ + (size_t)NUNIT * 4 * 16384;

struct Params {
  const float* x_prompt; const float* x_sample; const float* state_conv; const float* state_gdn; const float* state_hgrn;
  const float* norm_w; const float* w_in; const float* conv_w; const float* A_log; const float* dt_bias;
  const float* gdn_norm_w; const float* lb_logits; const float* hg_norm_w; const float* w_out; const float* final_norm_w;
  float* out; char* ws;
};

DI u32 pk2(float a, float b) { f32x2_t v = {a, b}; bf16x2_t r = __builtin_convertvector(v, bf16x2_t); return __builtin_bit_cast(u32, r); }
DI u16 f2b(float a) { return (u16)(pk2(a, 0.f) & 0xffffu); }
DI float b2f(u16 v) { return __uint_as_float(((u32)v) << 16); }
DI float rcpf_(float x) { return __builtin_amdgcn_rcpf(x); }
DI float sigmoidf_(float x) { return rcpf_(1.f + __expf(-x)); }
DI float siluf_(float x) { return x * rcpf_(1.f + __expf(-x)); }
DI const float* xrow(const Params& p, int r) { return r < T_P ? p.x_prompt + (size_t)r * DM : p.x_sample + (size_t)(r - T_P) * DM; }
DI bf16x8 ldfrag(const u16* base, int ld, int row0, int k0, int lane) {
  return *(const bf16x8*)(base + (size_t)(row0 + (lane & 15)) * ld + k0 + 8 * (lane >> 4));
}
DI int opaque_tid() { int t = threadIdx.x; asm volatile("" : "+v"(t)); return t; }
DI float4 ldnt4(const float* p) { f32x4 t = __builtin_nontemporal_load((const f32x4*)p); return make_float4(t[0], t[1], t[2], t[3]); }
DI uint2 ldnt_u2(const void* p) { typedef unsigned long long u64n; u64n t = __builtin_nontemporal_load((const u64n*)p); return make_uint2((u32)t, (u32)(t >> 32)); }
DI uint4 ldnt_u4(const void* p) { u32x4 t = __builtin_nontemporal_load((const u32x4*)p); return make_uint4(t[0], t[1], t[2], t[3]); }
DI bf16x8 ldfrag_nt(const u16* base, int ld, int row0, int k0, int lane) {
  u32x4 t = __builtin_nontemporal_load((const u32x4*)(base + (size_t)(row0 + (lane & 15)) * ld + k0 + 8 * (lane >> 4))); return __builtin_bit_cast(bf16x8, t);
}
DI f32x4 zero4() { f32x4 z = {0.f, 0.f, 0.f, 0.f}; return z; }

#define XB_TMO      128
#define XB_XCNT(j)  (256  + 64 * (j))
#define XB_XSUB(j)  (1280 + 64 * (j))
#define XB_XGEN(j)  (2304 + 64 * (j))
#define XB_TOP      3328
#define XB_TOPGEN   3392
#define XCD_BAR_WORDS 3456
#define XB_SPIN_CAP (1u << 18)
#define LAS __attribute__((address_space(3)))

__device__ __forceinline__ unsigned xb_ld(unsigned* p)              { return __hip_atomic_load(p, __ATOMIC_RELAXED, __HIP_MEMORY_SCOPE_AGENT); }
__device__ __forceinline__ unsigned xb_add(unsigned* p, unsigned v) { return __hip_atomic_fetch_add(p, v, __ATOMIC_RELAXED, __HIP_MEMORY_SCOPE_AGENT); }
__device__ __forceinline__ unsigned xb_xcc_id() { return (unsigned)__builtin_amdgcn_s_getreg((3 << 11) | 20) & 0xFu; }
#define XB_SPIN(cond, bar) do { unsigned _sp = 0; while (cond) { __builtin_amdgcn_s_sleep(1); \
    if ((++_sp & 255u) == 0u) { if (xb_ld(&(bar)[XB_TMO])) break; if (_sp > XB_SPIN_CAP) { atomicAdd(&(bar)[XB_TMO], 1u); break; } } } } while (0)

struct XcdBarrier {
    unsigned* bar; unsigned x;
    unsigned nloc, nx;
};

__device__ __forceinline__ XcdBarrier xcd_barrier_post(unsigned* bar) {
    XcdBarrier b; b.bar = bar; b.x = xb_xcc_id(); b.nloc = 0u; b.nx = 0u;
    if (threadIdx.x == 0) (void)xb_add(&bar[XB_XCNT(b.x)], 1u);
    return b;
}
__device__ __forceinline__ void xcd_barrier_complete(unsigned* bar, unsigned x, unsigned& nloc, unsigned& nx) {
    const unsigned G = gridDim.x * gridDim.y * gridDim.z;
    unsigned sum, cnt, mine, sp = 0u;
    for (;;) {
        sum = 0u; cnt = 0u; mine = 0u;
#pragma unroll
        for (unsigned j = 0; j < 16; ++j) { const unsigned c = xb_ld(&bar[XB_XCNT(j)]); sum += c; cnt += (c > 0u) ? 1u : 0u; mine = (j == x) ? c : mine; }
        if (sum == G) break;
        __builtin_amdgcn_s_sleep(1);
        if ((++sp & 255u) == 0u) { if (xb_ld(&bar[XB_TMO])) break; if (sp > XB_SPIN_CAP) { atomicAdd(&bar[XB_TMO], 1u); break; } }
    }
    nloc = mine > 0u ? mine : 1u; nx = cnt > 0u ? cnt : 1u;
}

__device__ __forceinline__ void xcd_barrier(XcdBarrier& b) {
    asm volatile("s_waitcnt vmcnt(0)" ::: "memory");
    __syncthreads();
    if (threadIdx.x == 0) {
        unsigned* bar = b.bar;
        __builtin_amdgcn_s_waitcnt(0);
        unsigned nloc = b.nloc, nx = b.nx;
        if (nloc == 0u) { xcd_barrier_complete(bar, b.x, nloc, nx); b.nloc = nloc; b.nx = nx; }
        const unsigned old = xb_add(&bar[XB_XSUB(b.x)], 1u);
        const unsigned gen = old / nloc;
        if (old + 1u == (gen + 1u) * nloc) {
            __builtin_amdgcn_fence(__ATOMIC_RELEASE, "agent");
            asm volatile("s_waitcnt vmcnt(0)" ::: "memory");
            const unsigned og = xb_add(&bar[XB_TOP], 1u);
            const unsigned tg = og / nx;
            if (og + 1u == (tg + 1u) * nx) xb_add(&bar[XB_TOPGEN], 1u);
            else XB_SPIN(xb_ld(&bar[XB_TOPGEN]) == tg, bar);
            __builtin_amdgcn_fence(__ATOMIC_ACQUIRE, "agent");
            xb_add(&bar[XB_XGEN(b.x)], 1u);
            asm volatile("s_waitcnt vmcnt(0)" ::: "memory");
        } else {
            XB_SPIN(xb_ld(&bar[XB_XGEN(b.x)]) == gen, bar);
            __builtin_amdgcn_fence(__ATOMIC_ACQUIRE, "agent");
            asm volatile("s_waitcnt vmcnt(0)" ::: "memory");
        }
    }
    __syncthreads();
}


static __device__ __forceinline__ void phase0(const Params& p, char* smem) {
  const int tid = opaque_tid(), lane = tid & 63, w = tid >> 6;
  u16* hbuf = (u16*)((char*)p.out + DO_H);
  u16* wtin = (u16*)(p.ws + WS_WIN);
  u16* wtout = (u16*)(p.ws + WS_WOUT);
  const int NT_RMS = T_ALL / 4, NT_WIN = (NWT / 64) * 16, NT_WOUT = 256;
  for (int task = blockIdx.x; task < NT_RMS + NT_WIN + NT_WOUT; task += gridDim.x) {
    if (task < NT_RMS) {
      int r = task * 4 + w;
      const float* xr = xrow(p, r);
      float4 v[4]; float ss = 0.f;
#pragma unroll
      for (int i = 0; i < 4; ++i) { v[i] = ldnt4(xr + i * 256 + lane * 4); ss += v[i].x * v[i].x + v[i].y * v[i].y + v[i].z * v[i].z + v[i].w * v[i].w; }
#pragma unroll
      for (int o = 32; o > 0; o >>= 1) ss += __shfl_xor(ss, o);
      float rs = rsqrtf(ss * (1.f / DM) + EPS);
#pragma unroll
      for (int i = 0; i < 4; ++i) {
        float4 nw = *(const float4*)(p.norm_w + i * 256 + lane * 4);
        uint2 o; o.x = pk2(v[i].x * rs * nw.x, v[i].y * rs * nw.y); o.y = pk2(v[i].z * rs * nw.z, v[i].w * rs * nw.w);
        *(uint2*)(hbuf + (size_t)r * DM + i * 256 + lane * 4) = o;
      }
    } else {
      float* tile = (float*)smem;
      int tt = task - NT_RMS; const float* src; u16* dst; int ldsrc, nt, kt; bool isin = tt < NT_WIN;
      if (isin) { nt = tt / 16; kt = tt % 16; src = p.w_in; ldsrc = 4112; dst = wtin; }
      else { tt -= NT_WIN; nt = tt / 16; kt = tt % 16; src = p.w_out; ldsrc = 1024; dst = wtout; }
      __syncthreads();
      for (int i = tid; i < 4096; i += 256) {
        int kk = i >> 6, nn = i & 63; int np_ = nt * 64 + nn; float val = 0.f;
        if (isin) {
          int orig = np_ < 2048 ? np_ : (np_ < 4096 ? np_ + 16 : (np_ < 4112 ? np_ - 2048 : -1));
          if (orig >= 0) val = src[(size_t)(kt * 64 + kk) * ldsrc + orig];
        } else val = src[(size_t)(kt * 64 + kk) * ldsrc + np_];
        tile[kk * 65 + nn] = val;
      }
      __syncthreads();
      for (int i = tid; i < 4096; i += 256) {
        int nn = i >> 6, kk = i & 63;
        dst[(size_t)(nt * 64 + nn) * DM + kt * 64 + kk] = f2b(tile[kk * 65 + nn]);
      }
    }
  }
}

DI int swz32(int row, int ch) { return row * 64 + ((ch ^ ((row >> 1) & 3)) << 4); }
struct GStg { u32x4 a[4], b[2]; };
DI void g_ld(GStg& r, const u16* ga, const u16* gb, int lda, int kt) {
#pragma unroll
  for (int i = 0; i < 4; ++i) r.a[i] = *(const u32x4*)(ga + (size_t)i * 64 * lda + kt * 32);
#pragma unroll
  for (int i = 0; i < 2; ++i) r.b[i] = *(const u32x4*)(gb + (size_t)i * 64 * DM + kt * 32);
}
DI void g_st(const GStg& r, char* buf, int srow, int sch) {
#pragma unroll
  for (int i = 0; i < 4; ++i) *(u32x4*)(buf + swz32(srow + i * 64, sch)) = r.a[i];
#pragma unroll
  for (int i = 0; i < 2; ++i) *(u32x4*)(buf + 16384 + swz32(srow + i * 64, sch)) = r.b[i];
}
DI void g_mma(const char* sa, f32x4 (&acc)[8][4], int wm, int wn, int l16, int q4) {
  const char* sb = sa + 16384;
  bf16x8 bfr[4], af[8];
#pragma unroll
  for (int j = 0; j < 4; ++j) bfr[j] = *(const bf16x8*)(sb + swz32(wn * 64 + j * 16 + l16, q4));
#pragma unroll
  for (int i = 0; i < 4; ++i) af[i] = *(const bf16x8*)(sa + swz32(wm * 128 + i * 16 + l16, q4));
  __builtin_amdgcn_sched_barrier(0);
#pragma unroll
  for (int i = 4; i < 8; ++i) af[i] = *(const bf16x8*)(sa + swz32(wm * 128 + i * 16 + l16, q4));
  __builtin_amdgcn_sched_barrier(0);
  __builtin_amdgcn_s_setprio(1);
#pragma unroll
  for (int i = 0; i < 4; ++i)
#pragma unroll
    for (int j = 0; j < 4; ++j) acc[i][j] = MFMA(bfr[j], af[i], acc[i][j]);
  __builtin_amdgcn_sched_barrier(0);
#pragma unroll
  for (int i = 4; i < 8; ++i)
#pragma unroll
    for (int j = 0; j < 4; ++j) acc[i][j] = MFMA(bfr[j], af[i], acc[i][j]);
  __builtin_amdgcn_s_setprio(0);
}

#define EPI_BARRIER() do { asm volatile("s_waitcnt lgkmcnt(0)" ::: "memory"); __builtin_amdgcn_s_barrier(); } while (0)
static __device__ __forceinline__ void gemm_tile(const u16* __restrict__ A, int lda, const u16* __restrict__ Bt, int m0, int n0, int k0, int nk, char* smem, f32x4 (&acc)[8][4],
                                                 bool pre_issued = false, bool has_next = false, int nm0 = 0, int nn0 = 0) {
  const int tid = opaque_tid(), lane = tid & 63, w = tid >> 6, wm = w >> 1, wn = w & 1, l16 = lane & 15, q4 = lane >> 4;
#pragma unroll
  for (int i = 0; i < 8; ++i)
#pragma unroll
    for (int j = 0; j < 4; ++j) acc[i][j] = zero4();
  const int srow = tid >> 2, ch = (tid & 3) ^ ((srow >> 1) & 3);
  const u16* ga = A + (size_t)(m0 + srow) * lda + ch * 8 + k0;
  const u16* gb = Bt + (size_t)(n0 + srow) * DM + ch * 8 + k0;
  char* lds_t = smem + tid * 16;
#define GEMM_ISSUE(GA, GB, BUF, KT) do { \
    _Pragma("unroll") for (int i_ = 0; i_ < 4; ++i_) \
      __builtin_amdgcn_global_load_lds((const unsigned*)((GA) + (size_t)i_ * 64 * lda + (KT) * 32), (unsigned*)(lds_t + (BUF) + i_ * 4096), 16, 0, 0); \
    _Pragma("unroll") for (int i_ = 0; i_ < 2; ++i_) \
      __builtin_amdgcn_global_load_lds((const unsigned*)((GB) + (size_t)i_ * 64 * DM + (KT) * 32), (unsigned*)(lds_t + (BUF) + 16384 + i_ * 4096), 16, 0, 0); \
  } while (0)
  if (!pre_issued) {
    __syncthreads();
    GEMM_ISSUE(ga, gb, 0, 0);
  }
  __syncthreads();
  for (int kt = 0; kt < nk; ++kt) {
    const int cur = (kt & 1) * 24576, nxt = ((kt + 1) & 1) * 24576;
    if (kt + 1 < nk) GEMM_ISSUE(ga, gb, nxt, kt + 1);
    __builtin_amdgcn_sched_barrier(0);
    g_mma(smem + cur, acc, wm, wn, l16, q4);
    __syncthreads();
  }
  if (has_next) {
    const u16* ga2 = A + (size_t)(nm0 + srow) * lda + ch * 8 + k0;
    const u16* gb2 = Bt + (size_t)(nn0 + srow) * DM + ch * 8 + k0;
    GEMM_ISSUE(ga2, gb2, 0, 0);
  }
#undef GEMM_ISSUE
}

static __device__ __forceinline__ void p1_tile(const Params& p, char* smem, int mt, int nt, bool pre_issued = false, bool has_next = false, int nmt = 0, int nnt = 0) {
  const int tid = opaque_tid(), lane = tid & 63, w = tid >> 6, wm = w >> 1, wn = w & 1, l16 = lane & 15, q4 = lane >> 4;
  const u16* hbuf = (const u16*)((char*)p.out + DO_H);
  const u16* wtin = (const u16*)(p.ws + WS_WIN);
  u16* P = (u16*)(p.ws + WS_P);
  float* ba = (float*)(p.ws + WS_BA);
  u16* stg = (u16*)(smem + 24576);
  f32x4 acc[8][4];
  gemm_tile(hbuf, DM, wtin, mt * 256, nt * 128, 0, 32, smem, acc, pre_issued, has_next, nmt * 256, nnt * 128);
  if (nt == 32) {
    if (wn == 0) {
#pragma unroll
      for (int mi = 0; mi < 8; ++mi) {
        int row = mt * 256 + wm * 128 + mi * 16 + l16;
        *(float4*)(ba + (size_t)row * 16 + 4 * q4) = make_float4(acc[mi][0][0], acc[mi][0][1], acc[mi][0][2], acc[mi][0][3]);
      }
    }
    return;
  }
  const bool convtile = nt < 12 && (mt == 128 || (mt & 31) == 31);
  if (convtile) {
#pragma unroll
    for (int mi = 0; mi < 8; ++mi)
#pragma unroll
      for (int ni = 0; ni < 4; ++ni)
#pragma unroll
        for (int i = 0; i < 4; ++i) {
          int row = mt * 256 + wm * 128 + mi * 16 + l16, col = nt * 128 + wn * 64 + ni * 16 + q4 * 4 + i;
          float v = acc[mi][ni][i];
          if (row < T_P) { int tt = row & 8191; if (tt >= 8189) p.out[OCP + ((size_t)(row >> 13) * 3 + (tt - 8189)) * 1536 + col] = v; }
          else { int rr = row - T_P, tt = rr & 15; if (tt >= 13) p.out[OCS + ((size_t)(rr >> 4) * 3 + (tt - 13)) * 1536 + col] = v; }
        }
  }
#pragma unroll
  for (int hh = 0; hh < 2; ++hh) {
    if (wm == hh) {
#pragma unroll
      for (int mi = 0; mi < 8; ++mi)
#pragma unroll
        for (int ni = 0; ni < 4; ++ni)
          *(uint2*)(stg + (mi * 16 + l16) * 136 + wn * 64 + ni * 16 + q4 * 4) = make_uint2(pk2(acc[mi][ni][0], acc[mi][ni][1]), pk2(acc[mi][ni][2], acc[mi][ni][3]));
    }
    EPI_BARRIER();
#pragma unroll
    for (int k = 0; k < 8; ++k) {
      int id = tid + 256 * k, row = id >> 4, cc = id & 15;
      *(u32x4*)(P + (size_t)(mt * 256 + hh * 128 + row) * NP + nt * 128 + cc * 8) = *(const u32x4*)(stg + row * 136 + cc * 8);
    }
    EPI_BARRIER();
  }
}

static __device__ __forceinline__ void phase1(const Params& p, char* smem) {
  const int G = gridDim.x;
  int x = blockIdx.x & 7, j = blockIdx.x >> 3, nj = (G + 7 - x) / 8;
  int nxcd = G < 8 ? G : 8;
  if (G < 8) { x = blockIdx.x; j = 0; nj = 1; }
  {
    int s = x, r = j; bool pre = false;
    while (s < 64 && r < 64) {
      int ns = s, nr = r + nj;
      if (nr >= 64) { ns = s + nxcd; nr = j; }
      const bool hn = ns < 64 && nr < 64;
      p1_tile(p, smem, (s >> 2) * 8 + (r & 7), (s & 3) * 8 + (r >> 3), pre, hn, (ns >> 2) * 8 + (nr & 7), (ns & 3) * 8 + (nr >> 3));
      pre = hn; s = ns; r = nr;
    }
  }
  for (int t = blockIdx.x; t < 32 + 129; t += G) {
    if (t < 32) p1_tile(p, smem, 128, t);
    else p1_tile(p, smem, t - 32, 32);
  }
}

DI int slotG(int unit, int h) { return unit < 512 ? (((unit >> 7) * 8 + h) * 128 + (unit & 127)) : (4096 + (unit - 512) * 8 + h); }
DI int slotH(int unit, int h) { return unit < 512 ? (((unit >> 7) * 4 + h) * 128 + (unit & 127)) : (2048 + (unit - 512) * 4 + h); }

struct GPre { u32x4 rg[7]; float bval, gval, alog, dtb; float2 cw[12]; float2 sc[9]; };

DI void gdn_prefetch(GPre& pre, const Params& p, int unit, int h, int tid) {
  const u16* P = (const u16*)(p.ws + WS_P);
  const float* ba = (const float*)(p.ws + WS_BA);
  const bool sample = unit >= 512;
  const int t0 = sample ? T_P + (unit - 512) * 16 : unit * 64;
  const int nv = sample ? 16 : 64;
  const int cseq = sample ? 0 : (unit & 127);
  const int lane = tid & 63, w = tid >> 6;
#pragma unroll
  for (int k = 0; k < 7; ++k) {
    const int id = tid + 256 * k;
    const int seg = id / 536, rem = id - seg * 536, row = rem >> 3, ch = rem & 7, r = row - 3;
    const bool ok = id < 1608 && (r >= 0 ? (r < nv) : (!sample && cseq > 0));
    u32x4 v = {0u, 0u, 0u, 0u};
    if (ok) v = __builtin_nontemporal_load((const u32x4*)(P + (size_t)(t0 + r) * NP + seg * 512 + h * 64 + ch * 8));
    pre.rg[k] = v;
  }
  pre.bval = 0.f; pre.gval = 0.f;
  if (tid < 64 && tid < nv) { pre.bval = ba[(size_t)(t0 + tid) * 16 + h]; pre.gval = ba[(size_t)(t0 + tid) * 16 + 8 + h]; }
  pre.alog = p.A_log[h]; pre.dtb = p.dt_bias[h];
#pragma unroll
  for (int s3 = 0; s3 < 3; ++s3) {
    const int col = s3 * 512 + h * 64 + (lane & 31) * 2;
#pragma unroll
    for (int jj = 0; jj < 4; ++jj) pre.cw[s3 * 4 + jj] = *(const float2*)(p.conv_w + jj * 1536 + col);
#pragma unroll
    for (int jj = 0; jj < 3; ++jj) {
      float2 v = make_float2(0.f, 0.f);
      if (sample && w == 0 && lane < 32) v = *(const float2*)(p.state_conv + ((size_t)(unit - 512) * 3 + jj) * 1536 + col);
      pre.sc[s3 * 3 + jj] = v;
    }
  }
}

static __device__ __forceinline__ void gdn_prep(const Params& p, int unit, int h, char* smem, GPre& pre, int nunit, int nh, bool hasnext) {
  const int tid = opaque_tid(), lane = tid & 63, w = tid >> 6, l16 = lane & 15, q4 = lane >> 4;
  const bool sample = unit >= 512;
  const int nv = sample ? 16 : 64;
  const int slot = slotG(unit, h);
  u16* qb = (u16*)smem;
  u16* kb = qb + 64 * 72;
  u16* vb = kb + 64 * 72;
  u16* kdT = vb;
  u16* wT = vb + 64 * 72;
  u16* uT = wT + 64 * 72;
  u16* Lb = uT + 64 * 72;
  u16* attn = Lb;
  float* Ld = (float*)(Lb + 64 * 72);
  u16* Tinv = (u16*)(Ld + 1024);
  float* s_gcum = (float*)(Tinv + 1024);
  float* s_beta = s_gcum + 64;
  float* s_rnk = s_beta + 64;
  float* s_rnq = s_rnk + 64;

  __syncthreads();
  u16* raw = wT;
#pragma unroll
  for (int k = 0; k < 7; ++k) {
    const int id = tid + 256 * k;
    if (id < 1608) *(u32x4*)(raw + id * 8) = pre.rg[k];
  }
  const float bval = pre.bval, gval = pre.gval, alog = pre.alog, dtb = pre.dtb;
  float2 cw[12], sc[9];
#pragma unroll
  for (int k = 0; k < 12; ++k) cw[k] = pre.cw[k];
#pragma unroll
  for (int k = 0; k < 9; ++k) sc[k] = pre.sc[k];
  if (hasnext) gdn_prefetch(pre, p, nunit, nh, tid);
  __syncthreads();
  {
    const int c2 = (lane & 31) * 2, tg8 = w * 2 + (lane >> 5);
#pragma unroll
    for (int s3 = 0; s3 < 3; ++s3) {
      float wa[4], wb[4];
#pragma unroll
      for (int jj = 0; jj < 4; ++jj) { wa[jj] = cw[s3 * 4 + jj].x; wb[jj] = cw[s3 * 4 + jj].y; }
      const u16* rs = raw + s3 * (67 * 64) + c2;
      float a3, a2, a1, b3, b2, b1;
      {
        const u32 h3 = *(const u32*)(rs + (tg8 * 8 + 0) * 64), h2 = *(const u32*)(rs + (tg8 * 8 + 1) * 64), h1 = *(const u32*)(rs + (tg8 * 8 + 2) * 64);
        const bool us = sample && tg8 == 0;
        a3 = us ? sc[s3 * 3].x : __uint_as_float(h3 << 16); b3 = us ? sc[s3 * 3].y : __uint_as_float(h3 & 0xffff0000u);
        a2 = us ? sc[s3 * 3 + 1].x : __uint_as_float(h2 << 16); b2 = us ? sc[s3 * 3 + 1].y : __uint_as_float(h2 & 0xffff0000u);
        a1 = us ? sc[s3 * 3 + 2].x : __uint_as_float(h1 << 16); b1 = us ? sc[s3 * 3 + 2].y : __uint_as_float(h1 & 0xffff0000u);
      }
      u16* dstb = s3 == 0 ? qb : (s3 == 1 ? kb : vb);
#pragma unroll
      for (int i = 0; i < 8; ++i) {
        const int tt = tg8 * 8 + i;
        float a0 = 0.f, b0 = 0.f;
        if (tt < nv) { u32 x = *(const u32*)(rs + (tt + 3) * 64); a0 = __uint_as_float(x << 16); b0 = __uint_as_float(x & 0xffff0000u); }
        float oa = wa[0] * a3 + wa[1] * a2 + wa[2] * a1 + wa[3] * a0;
        float ob = wb[0] * b3 + wb[1] * b2 + wb[2] * b1 + wb[3] * b0;
        oa = tt < nv ? siluf_(oa) : 0.f; ob = tt < nv ? siluf_(ob) : 0.f;
        *(u32*)(dstb + tt * 72 + c2) = pk2(oa, ob);
        a3 = a2; a2 = a1; a1 = a0; b3 = b2; b2 = b1; b1 = b0;
      }
    }
    if (tid < 64) {
      int tt = tid; float g = 0.f, be = 0.f;
      if (tt < nv) {
        be = sigmoidf_(bval);
        float xx = gval + dtb;
        float sp = fmaxf(xx, 0.f) + log1pf(__expf(-fabsf(xx)));
        g = -__expf(alog) * sp;
      }
#pragma unroll
      for (int o = 1; o < 64; o <<= 1) { float t = __shfl_up(g, o); if (lane >= o) g += t; }
      s_gcum[tt] = g; s_beta[tt] = be;
    }
  }
  __syncthreads();
  for (int i = tid; i < 2 * 64 * 72 / 8; i += 256) ((uint4*)wT)[i] = make_uint4(0, 0, 0, 0);
  f32x4 kk[4];
  {
    f32x4 qq = zero4();
#pragma unroll
    for (int ni = 0; ni < 4; ++ni) kk[ni] = zero4();
#pragma unroll
    for (int s = 0; s < 2; ++s) {
      bf16x8 a = ldfrag(kb, 72, 16 * w, 32 * s, lane);
#pragma unroll
      for (int ni = 0; ni < 4; ++ni) { bf16x8 b = ldfrag(kb, 72, 16 * ni, 32 * s, lane); kk[ni] = MFMA(a, b, kk[ni]); }
      bf16x8 aq = ldfrag(qb, 72, 16 * w, 32 * s, lane);
      qq = MFMA(aq, aq, qq);
    }
    if (q4 == (l16 >> 2)) {
      int ii = l16 & 3;
      f32x4 kd = w == 0 ? kk[0] : (w == 1 ? kk[1] : (w == 2 ? kk[2] : kk[3]));
      float dk_ = ii == 0 ? kd[0] : (ii == 1 ? kd[1] : (ii == 2 ? kd[2] : kd[3]));
      float dq_ = ii == 0 ? qq[0] : (ii == 1 ? qq[1] : (ii == 2 ? qq[2] : qq[3]));
      s_rnk[16 * w + l16] = rsqrtf(dk_ + EPS);
      s_rnq[16 * w + l16] = rsqrtf(dq_ + EPS) * 0.125f;
    }
  }
  __syncthreads();
  const float glast = s_gcum[63];
  float r_gc[4], r_brn[4], r_rnq[4], c_gc[4], c_rnk[4];
#pragma unroll
  for (int i = 0; i < 4; ++i) {
    const int row = 16 * w + 4 * q4 + i;
    r_gc[i] = s_gcum[row]; r_brn[i] = s_beta[row] * s_rnk[row]; r_rnq[i] = s_rnq[row];
    const int col = 16 * i + l16;
    c_gc[i] = s_gcum[col]; c_rnk[i] = s_rnk[col];
  }
#pragma unroll
  for (int ni = 0; ni < 4; ++ni)
#pragma unroll
    for (int i = 0; i < 4; ++i) {
      int row = 16 * w + 4 * q4 + i, col = 16 * ni + l16;
      float v = 0.f;
      if (row > col) v = r_brn[i] * c_rnk[ni] * kk[ni][i] * __expf(r_gc[i] - c_gc[ni]);
      Lb[row * 72 + col] = f2b(-v);
      if (ni == w) Ld[(w * 16 + 4 * q4 + i) * 16 + l16] = v;
    }
  __syncthreads();
  if (tid < 64) {
    const int blk = tid >> 4, j = tid & 15;
    const float* L = Ld + blk * 256;
    float X[16];
#pragma unroll
    for (int i = 0; i < 16; ++i) X[i] = (i == j) ? 1.f : 0.f;
#pragma unroll
    for (int i = 1; i < 16; ++i) {
      float a = X[i];
#pragma unroll
      for (int k = 0; k < i; ++k) a -= L[i * 16 + k] * X[k];
      X[i] = a;
    }
#pragma unroll
    for (int i = 0; i < 16; ++i) Tinv[(blk * 16 + i) * 16 + j] = f2b(X[i]);
  }
  __syncthreads();
  {
    u16* XT = w < 2 ? uT : wT;
    const u16* src = w < 2 ? vb : kb;
    f32x4 racc[4][2];
#pragma unroll
    for (int blk = 0; blk < 4; ++blk) {
      const float4 be4 = *(const float4*)(s_beta + 16 * blk + 4 * q4);
      float sc4[4] = {be4.x, be4.y, be4.z, be4.w};
      if (w >= 2) {
        const float4 rk = *(const float4*)(s_rnk + 16 * blk + 4 * q4), gc = *(const float4*)(s_gcum + 16 * blk + 4 * q4);
        sc4[0] *= rk.x * __expf(gc.x); sc4[1] *= rk.y * __expf(gc.y); sc4[2] *= rk.z * __expf(gc.z); sc4[3] *= rk.w * __expf(gc.w);
      }
#pragma unroll
      for (int tI = 0; tI < 2; ++tI) {
        const int cl = (w & 1) * 32 + tI * 16;
#pragma unroll
        for (int i = 0; i < 4; ++i) racc[blk][tI][i] = b2f(src[(16 * blk + 4 * q4 + i) * 72 + cl + l16]) * sc4[i];
      }
    }
#pragma unroll
    for (int blk = 0; blk < 4; ++blk) {
#pragma unroll
      for (int tI = 0; tI < 2; ++tI) {
        const int cl = (w & 1) * 32 + tI * 16;
        f32x4 acc = racc[blk][tI];
        if (blk > 0) {
#pragma unroll
          for (int s = 0; s < (blk + 1) / 2; ++s) {
            bf16x8 a = ldfrag(Lb, 72, 16 * blk, 32 * s, lane);
            if ((blk & 1) && s == (blk - 1) / 2 && q4 >= 2) a = (bf16x8){0, 0, 0, 0, 0, 0, 0, 0};
            bf16x8 b = ldfrag(XT, 72, cl, 32 * s, lane);
            acc = MFMA(a, b, acc);
          }
        }
        uint2 tv = *(const uint2*)(Tinv + (blk * 16 + l16) * 16 + 4 * q4);
        bf16x8 at = __builtin_bit_cast(bf16x8, make_uint4(tv.x, tv.y, 0u, 0u));
        bf16x8 by = __builtin_bit_cast(bf16x8, make_uint4(pk2(acc[0], acc[1]), pk2(acc[2], acc[3]), 0u, 0u));
        f32x4 xt = MFMA(at, by, zero4());
        *(uint2*)(XT + (cl + l16) * 72 + 16 * blk + 4 * q4) = make_uint2(pk2(xt[0], xt[1]), pk2(xt[2], xt[3]));
      }
    }
  }
  __syncthreads();
  {
    const int d = lane, tg = w;
    u32 pk[8];
    float tsc[16];
#pragma unroll
    for (int i = 0; i < 16; i += 4) {
      const float4 rk = *(const float4*)(s_rnk + tg * 16 + i), gc = *(const float4*)(s_gcum + tg * 16 + i);
      tsc[i] = rk.x * __expf(glast - gc.x); tsc[i + 1] = rk.y * __expf(glast - gc.y);
      tsc[i + 2] = rk.z * __expf(glast - gc.z); tsc[i + 3] = rk.w * __expf(glast - gc.w);
    }
#pragma unroll
    for (int i = 0; i < 16; i += 2) {
      int ta = tg * 16 + i, tb = ta + 1;
      float va = b2f(kb[ta * 72 + d]) * tsc[i];
      float vb_ = b2f(kb[tb * 72 + d]) * tsc[i + 1];
      pk[i >> 1] = pk2(va, vb_);
    }
    uint4* dst = (uint4*)(kdT + d * 72 + tg * 16);
    dst[0] = make_uint4(pk[0], pk[1], pk[2], pk[3]); dst[1] = make_uint4(pk[4], pk[5], pk[6], pk[7]);
  }
  {
    f32x4 qk[4];
#pragma unroll
    for (int ni = 0; ni < 4; ++ni) qk[ni] = zero4();
#pragma unroll
    for (int s = 0; s < 2; ++s) {
      bf16x8 a = ldfrag(qb, 72, 16 * w, 32 * s, lane);
#pragma unroll
      for (int ni = 0; ni < 4; ++ni) { bf16x8 b = ldfrag(kb, 72, 16 * ni, 32 * s, lane); qk[ni] = MFMA(a, b, qk[ni]); }
    }
#pragma unroll
    for (int ni = 0; ni < 4; ++ni)
#pragma unroll
      for (int i = 0; i < 4; ++i) {
        int row = 16 * w + 4 * q4 + i, col = 16 * ni + l16;
        float v = 0.f;
        if (row >= col) v = qk[ni][i] * r_rnq[i] * c_rnk[ni] * __expf(r_gc[i] - c_gc[ni]);
        attn[row * 72 + col] = f2b(v);
      }
  }
  __syncthreads();
  {
    u16* gM = (u16*)(p.ws + WS_GM) + (size_t)slot * 4096;
    u16* gN = (u16*)(p.ws + WS_GN) + (size_t)slot * 4096;
    u16* gO = (u16*)(p.ws + WS_GO) + (size_t)slot * 4096;
    u16* gQ = (u16*)((char*)p.out + DO_GQ) + (size_t)slot * 4096;
    f32x4 aM[4], aN[4], aW[4], aU[4];
#pragma unroll
    for (int ni = 0; ni < 4; ++ni) { aM[ni] = zero4(); aN[ni] = zero4(); aW[ni] = zero4(); aU[ni] = zero4(); }
#pragma unroll
    for (int s = 0; s < 2; ++s) {
      bf16x8 akd = ldfrag(kdT, 72, 16 * w, 32 * s, lane);
      bf16x8 aat = ldfrag(attn, 72, 16 * w, 32 * s, lane);
#pragma unroll
      for (int ni = 0; ni < 4; ++ni) {
        bf16x8 bw = ldfrag(wT, 72, 16 * ni, 32 * s, lane);
        bf16x8 bu = ldfrag(uT, 72, 16 * ni, 32 * s, lane);
        aM[ni] = MFMA(akd, bw, aM[ni]); aN[ni] = MFMA(akd, bu, aN[ni]);
        aW[ni] = MFMA(aat, bw, aW[ni]); aU[ni] = MFMA(aat, bu, aU[ni]);
      }
    }
    const float eg = __expf(glast);
#pragma unroll
    for (int ni = 0; ni < 4; ++ni) {
#pragma unroll
      for (int i = 0; i < 4; ++i) {
        int row = 16 * w + 4 * q4 + i, col = 16 * ni + l16;
        gM[row * 64 + col] = f2b((row == col ? eg : 0.f) - aM[ni][i]);
        float qv = b2f(qb[row * 72 + col]) * r_rnq[i] * __expf(r_gc[i]);
        gQ[row * 64 + col] = f2b(qv - aW[ni][i]);
      }
      *(uint2*)(gN + ((w * 64 + lane) * 4 + ni) * 4) = make_uint2(pk2(aN[ni][0], aN[ni][1]), pk2(aN[ni][2], aN[ni][3]));
      *(uint2*)(gO + ((w * 4 + ni) * 64 + lane) * 4) = make_uint2(pk2(aU[ni][0], aU[ni][1]), pk2(aU[ni][2], aU[ni][3]));
    }
  }
}

struct HPre { u32x4 rq[4], rf[4], rv[4]; float l0, l1; };
DI void hg_prefetch(HPre& pre, const Params& p, int unit, int h, int tid) {
  const u16* P = (const u16*)(p.ws + WS_P);
  const bool sample = unit >= 512;
  const int t0 = sample ? T_P + (unit - 512) * 16 : unit * 64;
  const int nv = sample ? 16 : 64;
#pragma unroll
  for (int k = 0; k < 4; ++k) {
    const int id = tid + 256 * k, row = id >> 4, cc = id & 15;
    u32x4 z = {0u, 0u, 0u, 0u};
    pre.rq[k] = z; pre.rf[k] = z; pre.rv[k] = z;
    if (row < nv) {
      const u16* pr = P + (size_t)(t0 + row) * NP + h * 128 + cc * 8;
      pre.rq[k] = __builtin_nontemporal_load((const u32x4*)(pr + PHQ)); pre.rf[k] = __builtin_nontemporal_load((const u32x4*)(pr + PHF)); pre.rv[k] = __builtin_nontemporal_load((const u32x4*)(pr + PHI));
    }
  }
  const int dg = h * 128 + (tid & 127);
  pre.l0 = p.lb_logits[dg]; pre.l1 = p.lb_logits[512 + dg];
}

static __device__ __forceinline__ void hg_prep(const Params& p, int unit, int h, char* smem, HPre& pre, int nunit, int nh, bool hasnext) {
  const int tid = opaque_tid(), lane = tid & 63, w = tid >> 6, l16 = lane & 15, q4 = lane >> 4;
  const bool sample = unit >= 512;
  const int nv = sample ? 16 : 64;
  const int slot = slotH(unit, h);
  u16* qt = (u16*)smem;
  u16* kt = (u16*)(smem + 18432);
  u16* vT = (u16*)(smem + 35840);
  u16* attn = (u16*)(smem + 54272);
  u16* kdT = (u16*)smem;
  float ebl = 0.f;
  __syncthreads();
#pragma unroll
  for (int k = 0; k < 4; ++k) {
    const int id = tid + 256 * k, row = id >> 4, cc = id & 15;
    *(u32x4*)(qt + row * 136 + cc * 8) = pre.rq[k];
    *(u32x4*)(kt + row * 136 + cc * 8) = pre.rf[k];
#pragma unroll
    for (int j = 0; j < 4; ++j) {
      vT[(cc * 8 + 2 * j) * 72 + row] = (u16)(pre.rv[k][j] & 0xffffu);
      vT[(cc * 8 + 2 * j + 1) * 72 + row] = (u16)(pre.rv[k][j] >> 16);
    }
  }
  const float lbv = sigmoidf_(pre.l0 - pre.l1);
  if (hasnext) hg_prefetch(pre, p, nunit, nh, tid);
  __syncthreads();
  if (tid < 128) {
    const int d = tid;
    const float lb = lbv;
    float b = 1.f;
#pragma unroll 4
    for (int t = 0; t < 64; ++t) {
      float qv = 0.f, kv = 0.f;
      if (t < nv) {
        float xx = b2f(kt[t * 136 + d]);
        float xq = b2f(qt[t * 136 + d]);
        float sg = sigmoidf_(xx);
        float f = lb + (1.f - lb) * sg;
        float omf = (1.f - lb) * (1.f - sg);
        b *= f;
        qv = siluf_(xq) * b; kv = omf * rcpf_(b);
      }
      qt[t * 136 + d] = f2b(qv); kt[t * 136 + d] = f2b(kv);
    }
    ebl = b;
    ((float*)(p.ws + WS_HDEC))[(size_t)slot * 128 + d] = ebl;
  }
  __syncthreads();
  f32x4 at[4];
#pragma unroll
  for (int ni = 0; ni < 4; ++ni) at[ni] = zero4();
#pragma unroll
  for (int s = 0; s < 4; ++s) {
    bf16x8 a = ldfrag(qt, 136, 16 * w, 32 * s, lane);
#pragma unroll
    for (int ni = 0; ni < 4; ++ni) { bf16x8 b = ldfrag(kt, 136, 16 * ni, 32 * s, lane); at[ni] = MFMA(a, b, at[ni]); }
  }
#pragma unroll
  for (int ni = 0; ni < 4; ++ni)
#pragma unroll
    for (int i = 0; i < 4; ++i) {
      int row = 16 * w + 4 * q4 + i, col = 16 * ni + l16;
      attn[row * 72 + col] = f2b(row >= col ? at[ni][i] : 0.f);
    }
  {
    u16* gq = (u16*)((char*)p.out + DO_HQ) + (size_t)slot * 8192;
#pragma unroll
    for (int k = 0; k < 4; ++k) {
      int id = tid + 256 * k, row = id >> 4, cc = id & 15;
      *(uint4*)(gq + row * 128 + cc * 8) = *(const uint4*)(qt + row * 136 + cc * 8);
    }
  }
  __syncthreads();
  if (tid < 128) {
    const int d = tid;
#pragma unroll 2
    for (int t = 0; t < 64; t += 8) {
      float kv[8];
#pragma unroll
      for (int k = 0; k < 8; ++k) kv[k] = b2f(kt[(t + k) * 136 + d]) * ebl;
      *(uint4*)(kdT + d * 72 + t) = make_uint4(pk2(kv[0], kv[1]), pk2(kv[2], kv[3]), pk2(kv[4], kv[5]), pk2(kv[6], kv[7]));
    }
  }
  __syncthreads();
  {
    u16* hD = (u16*)(p.ws + WS_HD) + (size_t)slot * 16384;
    u16* gOh = (u16*)((char*)p.out + DO_HO) + (size_t)slot * 8192;
#pragma unroll
    for (int mi = 0; mi < 2; ++mi) {
      f32x4 acc[8];
#pragma unroll
      for (int ni = 0; ni < 8; ++ni) acc[ni] = zero4();
#pragma unroll
      for (int s = 0; s < 2; ++s) {
        bf16x8 a = ldfrag(vT, 72, 32 * w + 16 * mi, 32 * s, lane);
#pragma unroll
        for (int ni = 0; ni < 8; ++ni) { bf16x8 b = ldfrag(kdT, 72, 16 * ni, 32 * s, lane); acc[ni] = MFMA(b, a, acc[ni]); }
      }
#pragma unroll
      for (int ni = 0; ni < 8; ++ni) {
        const int e = 32 * w + 16 * mi + l16, d = 16 * ni + 4 * q4;
        *(uint2*)(hD + e * 128 + d) = make_uint2(pk2(acc[ni][0], acc[ni][1]), pk2(acc[ni][2], acc[ni][3]));
      }
    }
    f32x4 ao[8];
#pragma unroll
    for (int ni = 0; ni < 8; ++ni) ao[ni] = zero4();
#pragma unroll
    for (int s = 0; s < 2; ++s) {
      bf16x8 a = ldfrag(attn, 72, 16 * w, 32 * s, lane);
#pragma unroll
      for (int ni = 0; ni < 8; ++ni) { bf16x8 b = ldfrag(vT, 72, 16 * ni, 32 * s, lane); ao[ni] = MFMA(a, b, ao[ni]); }
    }
#pragma unroll
    for (int ni = 0; ni < 8; ++ni)
      *(uint2*)(gOh + ((w * 8 + ni) * 64 + lane) * 4) = make_uint2(pk2(ao[ni][0], ao[ni][1]), pk2(ao[ni][2], ao[ni][3]));
  }
}

static __device__ __forceinline__ void phase2a(const Params& p, char* smem) {
  const int G = gridDim.x;
  GPre pre;
  if ((int)blockIdx.x < NUNIT * 8) gdn_prefetch(pre, p, blockIdx.x >> 3, blockIdx.x & 7, opaque_tid());
  for (int it = blockIdx.x; it < NUNIT * 8; it += G) {
    const int nx = it + G;
    gdn_prep(p, it >> 3, it & 7, smem, pre, nx >> 3, nx & 7, nx < NUNIT * 8);
  }
}

struct GStage { uint4 a[2]; uint4 n[2]; };

DI void gdn_load(GStage& st, const u16* gM, const u16* gN, int slot, int w, int lane) {
  const int l16 = lane & 15, q4 = lane >> 4;
  const u16* m = gM + (size_t)slot * 4096 + (16 * w + l16) * 64 + 8 * q4;
  st.a[0] = *(const uint4*)(m); st.a[1] = *(const uint4*)(m + 32);
  const u16* n = gN + (size_t)slot * 4096 + (w * 64 + lane) * 16;
  st.n[0] = *(const uint4*)(n); st.n[1] = *(const uint4*)(n + 8);
}

DI void gdn_step(f32x4 (&S)[4], const GStage& st, u16* gS, int slot, int w, int lane, u16* ST) {
  const int l16 = lane & 15, q4 = lane >> 4;
  uint2 sp[4];
#pragma unroll
  for (int ni = 0; ni < 4; ++ni) {
    sp[ni] = make_uint2(pk2(S[ni][0], S[ni][1]), pk2(S[ni][2], S[ni][3]));
    *(uint2*)(ST + (16 * ni + l16) * 72 + 16 * w + 4 * q4) = sp[ni];
  }
  u16* dst = gS + (size_t)slot * 4096 + (w * 64 + lane) * 16;
  *(uint4*)(dst) = make_uint4(sp[0].x, sp[0].y, sp[1].x, sp[1].y);
  *(uint4*)(dst + 8) = make_uint4(sp[2].x, sp[2].y, sp[3].x, sp[3].y);
  __syncthreads();
  bf16x8 a0 = __builtin_bit_cast(bf16x8, st.a[0]), a1 = __builtin_bit_cast(bf16x8, st.a[1]);
  const u32 nn[8] = {st.n[0].x, st.n[0].y, st.n[0].z, st.n[0].w, st.n[1].x, st.n[1].y, st.n[1].z, st.n[1].w};
#pragma unroll
  for (int ni = 0; ni < 4; ++ni) {
    f32x4 acc;
    acc[0] = __uint_as_float(nn[2 * ni] << 16); acc[1] = __uint_as_float(nn[2 * ni] & 0xffff0000u);
    acc[2] = __uint_as_float(nn[2 * ni + 1] << 16); acc[3] = __uint_as_float(nn[2 * ni + 1] & 0xffff0000u);
    bf16x8 b0 = ldfrag(ST, 72, 16 * ni, 0, lane);
    bf16x8 b1 = ldfrag(ST, 72, 16 * ni, 32, lane);
    acc = MFMA(a0, b0, acc);
    acc = MFMA(a1, b1, acc);
    S[ni] = acc;
  }
}

static __device__ __forceinline__ void gdn_scan_wg(const Params& p, int task, char* smem) {
  const int tid = opaque_tid(), lane = tid & 63, w = tid >> 6, l16 = lane & 15, q4 = lane >> 4;
  const u16* gM = (const u16*)(p.ws + WS_GM);
  const u16* gN = (const u16*)(p.ws + WS_GN);
  u16* gS = (u16*)(p.ws + WS_GS);
  u16* ST0 = (u16*)smem; u16* ST1 = ST0 + 64 * 72;
  f32x4 S[4];
  __syncthreads();
  if (task < 32) {
    const int base = task * 128;
#pragma unroll
    for (int ni = 0; ni < 4; ++ni) S[ni] = zero4();
    GStage st[10];
#pragma unroll
    for (int k = 0; k < 10; ++k) gdn_load(st[k], gM, gN, base + k, w, lane);
    for (int c0 = 0; c0 < 130; c0 += 10) {
#pragma unroll
      for (int k = 0; k < 10; ++k) {
        const int c = c0 + k;
        if (c < 128) {
          gdn_step(S, st[k], gS, base + c, w, lane, (k & 1) ? ST1 : ST0);
          if (c + 10 < 128) gdn_load(st[k], gM, gN, base + c + 10, w, lane);
        }
      }
    }
    float* o = p.out + OGP + (size_t)task * 4096;
#pragma unroll
    for (int ni = 0; ni < 4; ++ni)
#pragma unroll
      for (int i = 0; i < 4; ++i) o[(16 * w + 4 * q4 + i) * 64 + ni * 16 + l16] = S[ni][i];
  } else {
    const int k = task - 32;
    const float* s0 = p.state_gdn + (size_t)k * 4096;
#pragma unroll
    for (int ni = 0; ni < 4; ++ni)
#pragma unroll
      for (int i = 0; i < 4; ++i) S[ni][i] = s0[(16 * w + 4 * q4 + i) * 64 + ni * 16 + l16];
    GStage st;
    const int slot = 4096 + k;
    gdn_load(st, gM, gN, slot, w, lane);
    gdn_step(S, st, gS, slot, w, lane, ST0);
    float* o = p.out + OGS + (size_t)k * 4096;
#pragma unroll
    for (int ni = 0; ni < 4; ++ni)
#pragma unroll
      for (int i = 0; i < 4; ++i) o[(16 * w + 4 * q4 + i) * 64 + ni * 16 + l16] = S[ni][i];
  }
}

struct HStage { uint2 dl; float4 dc; };
DI void hg_ld(HStage& st, const u16* hD, const float* hdec, int slot, int el4, int d0) {
  st.dl = *(const uint2*)(hD + (size_t)slot * 16384 + el4 * 4);
  st.dc = *(const float4*)(hdec + (size_t)slot * 128 + d0);
}
DI void hg_st(float (&S)[4], const HStage& st, u16* hD, int slot, int el4) {
  *(uint2*)(hD + (size_t)slot * 16384 + el4 * 4) = make_uint2(pk2(S[0], S[1]), pk2(S[2], S[3]));
  S[0] = st.dc.x * S[0] + __uint_as_float(st.dl.x << 16); S[1] = st.dc.y * S[1] + __uint_as_float(st.dl.x & 0xffff0000u);
  S[2] = st.dc.z * S[2] + __uint_as_float(st.dl.y << 16); S[3] = st.dc.w * S[3] + __uint_as_float(st.dl.y & 0xffff0000u);
}

static __device__ __forceinline__ void hg_scan_wg(const Params& p, int task, char* smem) {
  const int tid = opaque_tid();
  u16* hD = (u16*)(p.ws + WS_HD);
  const float* hdec = (const float*)(p.ws + WS_HDEC);
  float* tile = (float*)smem;
  const int td = tid >> 1, th = tid & 1;
  float S[4];
  float* o;
  const int part = task & 15;
  const int el4 = (part << 8) + tid, d0 = (el4 & 31) * 4, e0 = part * 8, el = tid >> 5;
  __syncthreads();
  if (task < 256) {
    const int bh = task >> 4;
    const int base = bh * 128;
#pragma unroll
    for (int k = 0; k < 4; ++k) S[k] = 0.f;
    HStage st[16];
#pragma unroll
    for (int k = 0; k < 16; ++k) hg_ld(st[k], hD, hdec, base + k, el4, d0);
    for (int c0 = 0; c0 < 128; c0 += 16) {
#pragma unroll
      for (int k = 0; k < 16; ++k) {
        const int c = c0 + k;
        hg_st(S, st[k], hD, base + c, el4);
        if (c + 16 < 128) hg_ld(st[k], hD, hdec, base + c + 16, el4, d0);
      }
    }
    o = p.out + OHP + (size_t)bh * 16384;
  } else {
    const int bh = (task - 256) >> 4;
    const float* s0 = p.state_hgrn + (size_t)bh * 16384;
    HStage st;
    const int slot = 2048 + bh;
    hg_ld(st, hD, hdec, slot, el4, d0);
    {
      float4 v = *(const float4*)(s0 + td * 128 + e0 + th * 4);
      tile[(th * 4 + 0) * 132 + td] = v.x; tile[(th * 4 + 1) * 132 + td] = v.y;
      tile[(th * 4 + 2) * 132 + td] = v.z; tile[(th * 4 + 3) * 132 + td] = v.w;
    }
    __syncthreads();
    {
      float4 v = *(const float4*)(tile + el * 132 + d0);
      S[0] = v.x; S[1] = v.y; S[2] = v.z; S[3] = v.w;
    }
    __syncthreads();
    hg_st(S, st, hD, slot, el4);
    o = p.out + OHS + (size_t)bh * 16384;
  }
  *(float4*)(tile + el * 132 + d0) = make_float4(S[0], S[1], S[2], S[3]);
  __syncthreads();
  {
    float4 v;
    v.x = tile[(th * 4 + 0) * 132 + td]; v.y = tile[(th * 4 + 1) * 132 + td];
    v.z = tile[(th * 4 + 2) * 132 + td]; v.w = tile[(th * 4 + 3) * 132 + td];
    *(float4*)(o + td * 128 + e0 + th * 4) = v;
  }
}

static __device__ __forceinline__ void phase3a(const Params& p, char* smem) {
  const int G = gridDim.x;
  if (G > 64) {
    if (blockIdx.x < 32) gdn_scan_wg(p, blockIdx.x, smem);
    else if (G == 512 && blockIdx.x >= 256 && blockIdx.x < 288) {
    } else {
      HPre pre;
      const int st = G == 512 ? G - 64 : G - 32;
      const int i0 = G == 512 ? (blockIdx.x < 256 ? blockIdx.x - 32 : blockIdx.x - 64) : blockIdx.x - 32;
      if (i0 < NUNIT * 4) hg_prefetch(pre, p, i0 >> 2, i0 & 3, opaque_tid());
      for (int it = i0; it < NUNIT * 4; it += st) { const int nx = it + st; hg_prep(p, it >> 2, it & 3, smem, pre, nx >> 2, nx & 3, nx < NUNIT * 4); }
    }
  } else {
    for (int task = blockIdx.x; task < 32; task += G) gdn_scan_wg(p, task, smem);
    HPre pre;
    if ((int)blockIdx.x < NUNIT * 4) hg_prefetch(pre, p, blockIdx.x >> 2, blockIdx.x & 3, opaque_tid());
    for (int it = blockIdx.x; it < NUNIT * 4; it += G) { const int nx = it + G; hg_prep(p, it >> 2, it & 3, smem, pre, nx >> 2, nx & 3, nx < NUNIT * 4); }
  }
}
static __device__ __forceinline__ void p4_item(const Params& p, int unit, int hh);
static __device__ __forceinline__ void phase3b(const Params& p, char* smem) {
  for (int task = blockIdx.x; task < 256 + 128 + 1024; task += gridDim.x) {
    if (task < 256) hg_scan_wg(p, task, smem);
    else if (task < 384) gdn_scan_wg(p, 32 + task - 256, smem);
    else hg_scan_wg(p, 256 + task - 384, smem);
  }
  for (int it = blockIdx.x; it < 512 * 8; it += gridDim.x) p4_item(p, it >> 3, it & 7);
}

static __device__ __forceinline__ void p4_item(const Params& p, int unit, int hh) {
  const int tid = opaque_tid(), lane = tid & 63, w = tid >> 6, l16 = lane & 15, q4 = lane >> 4;
  u16* P = (u16*)(p.ws + WS_P);
  {
    const bool sample = unit >= 512;
    const int t0 = sample ? T_P + (unit - 512) * 16 : unit * 64;
    if (sample && w > 0) return;
    if (hh < 8) {
      const int slot = slotG(unit, hh);
      const u16* gQ = (const u16*)((char*)p.out + DO_GQ) + (size_t)slot * 4096;
      const u16* gS = (const u16*)(p.ws + WS_GS) + (size_t)slot * 4096;
      const u16* gO = (const u16*)(p.ws + WS_GO) + (size_t)slot * 4096;
      f32x4 acc[4];
      u16 zr[4][4]; float nwr[4];
      {
        const u16* zp = P + (size_t)(t0 + 16 * w + 4 * q4) * NP + PZA + hh * 64 + l16;
#pragma unroll
        for (int ni = 0; ni < 4; ++ni) {
          nwr[ni] = p.gdn_norm_w[16 * ni + l16];
#pragma unroll
          for (int i = 0; i < 4; ++i) zr[ni][i] = zp[(size_t)i * NP + 16 * ni];
        }
      }
#pragma unroll
      for (int ni = 0; ni < 4; ++ni) {
        uint2 ov = ldnt_u2(gO + ((w * 4 + ni) * 64 + lane) * 4);
        acc[ni][0] = __uint_as_float(ov.x << 16); acc[ni][1] = __uint_as_float(ov.x & 0xffff0000u);
        acc[ni][2] = __uint_as_float(ov.y << 16); acc[ni][3] = __uint_as_float(ov.y & 0xffff0000u);
      }
#pragma unroll
      for (int s = 0; s < 2; ++s) {
        const u16* qa = gQ + (16 * w + l16) * 64 + 32 * s + 4 * q4;
        const uint2 alo = ldnt_u2(qa), ahi = ldnt_u2(qa + 16);
        bf16x8 a = __builtin_bit_cast(bf16x8, make_uint4(alo.x, alo.y, ahi.x, ahi.y));
        const u16* sb0 = gS + ((2 * s) * 64 + lane) * 16;
        const u16* sb1 = gS + ((2 * s + 1) * 64 + lane) * 16;
        const uint4 l0 = ldnt_u4(sb0), l1 = ldnt_u4(sb0 + 8), h0 = ldnt_u4(sb1), h1 = ldnt_u4(sb1 + 8);
        const u32 lo[8] = {l0.x, l0.y, l0.z, l0.w, l1.x, l1.y, l1.z, l1.w};
        const u32 hi[8] = {h0.x, h0.y, h0.z, h0.w, h1.x, h1.y, h1.z, h1.w};
#pragma unroll
        for (int ni = 0; ni < 4; ++ni) {
          bf16x8 b = __builtin_bit_cast(bf16x8, make_uint4(lo[2 * ni], lo[2 * ni + 1], hi[2 * ni], hi[2 * ni + 1]));
          acc[ni] = MFMA(a, b, acc[ni]);
        }
      }
      float ss[4];
#pragma unroll
      for (int i = 0; i < 4; ++i) {
        float s_ = 0.f;
#pragma unroll
        for (int ni = 0; ni < 4; ++ni) s_ += acc[ni][i] * acc[ni][i];
        s_ += __shfl_xor(s_, 1); s_ += __shfl_xor(s_, 2); s_ += __shfl_xor(s_, 4); s_ += __shfl_xor(s_, 8);
        ss[i] = rsqrtf(s_ * (1.f / 64.f) + EPS);
      }
#pragma unroll
      for (int ni = 0; ni < 4; ++ni) {
        const int e = 16 * ni + l16; const float nw = nwr[ni];
#pragma unroll
        for (int i = 0; i < 4; ++i) {
          int tok = t0 + 16 * w + 4 * q4 + i;
          float z = b2f(zr[ni][i]);
          P[(size_t)tok * NP + hh * 64 + e] = f2b(acc[ni][i] * ss[i] * nw * siluf_(z));
        }
      }
    } else {
      const int h = hh - 8, slot = slotH(unit, h);
      const u16* gq = (const u16*)((char*)p.out + DO_HQ) + (size_t)slot * 8192;
      const u16* gOh = (const u16*)((char*)p.out + DO_HO) + (size_t)slot * 8192;
      const u16* hS = (const u16*)(p.ws + WS_HD) + (size_t)slot * 16384;
      f32x4 acc[8];
      u16 zr[8][4]; float nwr[8];
      {
        const u16* zp = P + (size_t)(t0 + 16 * w + 4 * q4) * NP + PZB + h * 128 + l16;
#pragma unroll
        for (int ni = 0; ni < 8; ++ni) {
          nwr[ni] = p.hg_norm_w[16 * ni + l16];
#pragma unroll
          for (int i = 0; i < 4; ++i) zr[ni][i] = zp[(size_t)i * NP + 16 * ni];
        }
      }
#pragma unroll
      for (int ni = 0; ni < 8; ++ni) {
        uint2 ov = ldnt_u2(gOh + ((w * 8 + ni) * 64 + lane) * 4);
        acc[ni][0] = __uint_as_float(ov.x << 16); acc[ni][1] = __uint_as_float(ov.x & 0xffff0000u);
        acc[ni][2] = __uint_as_float(ov.y << 16); acc[ni][3] = __uint_as_float(ov.y & 0xffff0000u);
      }
#pragma unroll
      for (int s = 0; s < 4; ++s) {
        bf16x8 a = ldfrag_nt(gq, 128, 16 * w, 32 * s, lane);
#pragma unroll
        for (int ni = 0; ni < 8; ++ni) { bf16x8 b = ldfrag_nt(hS, 128, 16 * ni, 32 * s, lane); acc[ni] = MFMA(a, b, acc[ni]); }
      }
      float ss[4];
#pragma unroll
      for (int i = 0; i < 4; ++i) {
        float s_ = 0.f;
#pragma unroll
        for (int ni = 0; ni < 8; ++ni) s_ += acc[ni][i] * acc[ni][i];
        s_ += __shfl_xor(s_, 1); s_ += __shfl_xor(s_, 2); s_ += __shfl_xor(s_, 4); s_ += __shfl_xor(s_, 8);
        ss[i] = rsqrtf(s_ * (1.f / 128.f) + EPS);
      }
#pragma unroll
      for (int ni = 0; ni < 8; ++ni) {
        const int e = 16 * ni + l16; const float nw = nwr[ni];
#pragma unroll
        for (int i = 0; i < 4; ++i) {
          int tok = t0 + 16 * w + 4 * q4 + i;
          float z = b2f(zr[ni][i]);
          P[(size_t)tok * NP + 512 + h * 128 + e] = f2b(acc[ni][i] * ss[i] * nw * siluf_(z));
        }
      }
    }
  }
}

static __device__ __forceinline__ void phase4(const Params& p) {
  for (int it = blockIdx.x; it < NUNIT * 4 + 16 * 8; it += gridDim.x) {
    if (it < NUNIT * 4) p4_item(p, it >> 2, 8 + (it & 3));
    else { const int k = it - NUNIT * 4; p4_item(p, 512 + (k >> 3), k & 7); }
  }
}

static __device__ __forceinline__ void phase5(const Params& p, char* smem) {
  const int tid = opaque_tid(), lane = tid & 63, w = tid >> 6, wm = w >> 1, wn = w & 1, l16 = lane & 15, q4 = lane >> 4;
  const u16* obuf = (const u16*)(p.ws + WS_P);
  const u16* wtout = (const u16*)(p.ws + WS_WOUT);
  u16* ytmp = (u16*)(p.ws + WS_GM);
  u16* stg = (u16*)(smem + 24576);
  float* part = (float*)(p.ws + WS_PART);
  const int G = gridDim.x;
  int x = blockIdx.x & 7, j = blockIdx.x >> 3, nj = (G + 7 - x) / 8, nxcd = 8;
  if (G < 8) { x = blockIdx.x; j = 0; nj = 1; nxcd = G; }
  const int nmt = (128 - x + nxcd - 1) / nxcd;
  bool pre = false;
  for (int li = j; li < nmt * 8; li += nj) {
    const int mt = x + (li >> 3) * nxcd, nt = li & 7;
    const int nli = li + nj; const bool hn = nli < nmt * 8;
    f32x4 acc[8][4];
    gemm_tile(obuf, NP, wtout, mt * 256, nt * 128, 0, 32, smem, acc, pre, hn, (x + (nli >> 3) * nxcd) * 256, (nli & 7) * 128);
    pre = hn;
#pragma unroll
    for (int hh = 0; hh < 2; ++hh) {
      if (wm == hh) {
#pragma unroll
        for (int mi = 0; mi < 8; ++mi)
#pragma unroll
          for (int ni = 0; ni < 4; ++ni)
            *(uint2*)(stg + (mi * 16 + l16) * 136 + wn * 64 + ni * 16 + q4 * 4) = make_uint2(pk2(acc[mi][ni][0], acc[mi][ni][1]), pk2(acc[mi][ni][2], acc[mi][ni][3]));
      }
      EPI_BARRIER();
#pragma unroll
      for (int k = 0; k < 8; ++k) {
        int id = tid + 256 * k, row = id >> 4, cc = id & 15;
        *(u32x4*)(ytmp + (size_t)(mt * 256 + hh * 128 + row) * DM + nt * 128 + cc * 8) = *(const u32x4*)(stg + row * 136 + cc * 8);
      }
      EPI_BARRIER();
    }
  }
  for (int q = blockIdx.x; q < 64; q += G) {
    const int nt = q >> 3, kq = q & 7;
    f32x4 acc[8][4];
    gemm_tile(obuf, NP, wtout, 128 * 256, nt * 128, kq * 128, 4, smem, acc);
    int rb2 = kq * 256 + wm * 128 + l16;
#pragma unroll
    for (int mi = 0; mi < 8; ++mi) {
      asm volatile("" : "+v"(rb2));
      float* pr = part + (size_t)(rb2 + mi * 16) * DM + nt * 128 + wn * 64 + q4 * 4;
#pragma unroll
      for (int ni = 0; ni < 4; ++ni) *(float4*)(pr + ni * 16) = make_float4(acc[mi][ni][0], acc[mi][ni][1], acc[mi][ni][2], acc[mi][ni][3]);
    }
  }
}

static __device__ __forceinline__ void phase6(const Params& p) {
  const int tid = opaque_tid(), lane = tid & 63, w = tid >> 6;
  const u16* ytmp = (const u16*)(p.ws + WS_GM);
  const float* part = (const float*)(p.ws + WS_PART);
  float4 nw[4];
#pragma unroll
  for (int i = 0; i < 4; ++i) nw[i] = *(const float4*)(p.final_norm_w + i * 256 + lane * 4);
  for (int task = blockIdx.x; task < T_P / 16; task += gridDim.x) {
    const int r0 = task * 16 + w * 4;
    {
      float4 v[4][4]; uint2 ow[4][4];
#pragma unroll
      for (int r = 0; r < 4; ++r) {
        const float* xr = p.x_prompt + (size_t)(r0 + r) * DM;
        const u16* yr = ytmp + (size_t)(r0 + r) * DM;
#pragma unroll
        for (int i = 0; i < 4; ++i) { v[r][i] = ldnt4(xr + i * 256 + lane * 4); ow[r][i] = ldnt_u2(yr + i * 256 + lane * 4); }
      }
#pragma unroll
      for (int r = 0; r < 4; ++r) {
        float s = 0.f;
#pragma unroll
        for (int i = 0; i < 4; ++i) {
          float4 t = v[r][i];
          t.x += __uint_as_float(ow[r][i].x << 16); t.y += __uint_as_float(ow[r][i].x & 0xffff0000u);
          t.z += __uint_as_float(ow[r][i].y << 16); t.w += __uint_as_float(ow[r][i].y & 0xffff0000u);
          v[r][i] = t; s += t.x * t.x + t.y * t.y + t.z * t.z + t.w * t.w;
        }
#pragma unroll
        for (int o = 32; o > 0; o >>= 1) s += __shfl_xor(s, o);
        const float rs = rsqrtf(s * (1.f / DM) + EPS);
        float* yo = p.out + OY + (size_t)(r0 + r) * DM;
#pragma unroll
        for (int i = 0; i < 4; ++i) {
          float4 t = v[r][i];
          t.x *= rs * nw[i].x; t.y *= rs * nw[i].y; t.z *= rs * nw[i].z; t.w *= rs * nw[i].w;
          { f32x4 tv = {t.x, t.y, t.z, t.w}; __builtin_nontemporal_store(tv, (f32x4*)(yo + i * 256 + lane * 4)); }
        }
      }
    }
  }
  {
    const int nwaves = gridDim.x * 4;
    {
#pragma unroll 1
      for (int rl = blockIdx.x * 4 + w; rl < T_ALL - T_P; rl += nwaves) {
        float4 v[4]; float ss = 0.f;
#pragma unroll
        for (int i = 0; i < 4; ++i) {
          float4 t = *(const float4*)(p.x_sample + (size_t)rl * DM + i * 256 + lane * 4);
#pragma unroll
          for (int kq = 0; kq < 8; ++kq) {
            float4 u = *(const float4*)(part + ((size_t)kq * 256 + rl) * DM + i * 256 + lane * 4);
            t.x += u.x; t.y += u.y; t.z += u.z; t.w += u.w;
          }
          v[i] = t; ss += t.x * t.x + t.y * t.y + t.z * t.z + t.w * t.w;
        }
#pragma unroll
        for (int o = 32; o > 0; o >>= 1) ss += __shfl_xor(ss, o);
        const float rs = rsqrtf(ss * (1.f / DM) + EPS);
        float* yr = p.out + OY + (size_t)(T_P + rl) * DM;
#pragma unroll
        for (int i = 0; i < 4; ++i) {
          float4 t = v[i];
          t.x *= rs * nw[i].x; t.y *= rs * nw[i].y; t.z *= rs * nw[i].z; t.w *= rs * nw[i].w;
          *(float4*)(yr + i * 256 + lane * 4) = t;
        }
      }
    }
  }
}

__global__ void __launch_bounds__(256, 2) fwd_megakernel(Params p) {
  __shared__ __attribute__((aligned(16))) char smem[65536];
  cg::grid_group grid = cg::this_grid();
  XcdBarrier xb = xcd_barrier_post((unsigned*)(p.ws + WS_BAR));
  if (p.out == nullptr) grid.sync();
  phase0(p, smem);
  xcd_barrier(xb);
  phase1(p, smem);
  xcd_barrier(xb);
  phase2a(p, smem);
  xcd_barrier(xb);
  phase3a(p, smem);
  xcd_barrier(xb);
  phase3b(p, smem);
  xcd_barrier(xb);
  phase4(p);
  xcd_barrier(xb);
  phase5(p, smem);
  xcd_barrier(xb);
  phase6(p);
}

extern "C" void kernel_launch(void* const* d_in, const int* in_sizes, int n_in, void* d_out, int out_size, void* d_ws, size_t ws_size,
                              hipStream_t stream) {
  static int grid_blocks = 0;
  if (!grid_blocks) {
    int dev = 0, cus = 0, per_cu = 0;
    hipGetDevice(&dev);
    hipDeviceGetAttribute(&cus, hipDeviceAttributeMultiprocessorCount, dev);
    hipOccupancyMaxActiveBlocksPerMultiprocessor(&per_cu, fwd_megakernel, 256, 0);
    if (per_cu > 2) per_cu = 2;
    if (per_cu < 1) per_cu = 1;
    grid_blocks = cus * per_cu;
  }
  if (ws_size < WS_END) { fprintf(stderr, "workspace too small\n"); return; }
  Params p{};
  p.x_prompt = (const float*)d_in[0]; p.x_sample = (const float*)d_in[1]; p.state_conv = (const float*)d_in[2];
  p.state_gdn = (const float*)d_in[3]; p.state_hgrn = (const float*)d_in[4]; p.norm_w = (const float*)d_in[5];
  p.w_in = (const float*)d_in[6]; p.conv_w = (const float*)d_in[7]; p.A_log = (const float*)d_in[8]; p.dt_bias = (const float*)d_in[9];
  p.gdn_norm_w = (const float*)d_in[10]; p.lb_logits = (const float*)d_in[11]; p.hg_norm_w = (const float*)d_in[12];
  p.w_out = (const float*)d_in[13]; p.final_norm_w = (const float*)d_in[14];
  p.out = (float*)d_out; p.ws = (char*)d_ws;
  hipMemsetAsync((char*)d_ws + WS_BAR, 0, 16384, stream);
  void* args[] = {&p};
  hipError_t e = hipLaunchCooperativeKernel((void*)fwd_megakernel, dim3(grid_blocks), dim3(256), args, 0, stream);
  if (e != hipSuccess) fprintf(stderr, "cooperative launch failed: %s (grid %d)\n", hipGetErrorString(e), grid_blocks);
}
```

```cpp
#include <hip/hip_runtime.h>
#include <hip/hip_cooperative_groups.h>
#include <cstdio>
namespace cg = cooperative_groups;

typedef unsigned short u16;
typedef unsigned int u32;
using bf16x8 = __attribute__((ext_vector_type(8))) short;
using f32x4 = __attribute__((ext_vector_type(4))) float;
using u32x4 = __attribute__((ext_vector_type(4))) unsigned;
typedef __bf16 bf16x2_t __attribute__((ext_vector_type(2)));
typedef float f32x2_t __attribute__((ext_vector_type(2)));
#define DI __device__ __forceinline__
#define MFMA(a, b, c) __builtin_amdgcn_mfma_f32_16x16x32_bf16((a), (b), (c), 0, 0, 0)

constexpr int T_ALL = 33024, T_P = 32768, DM = 1024, NP = 4096, NWT = 4224;
constexpr int NUNIT = 528;
constexpr int PQ = 0, PK = 512, PV = 1024, PZA = 1536, PHQ = 2048, PHF = 2560, PHI = 3072, PZB = 3584;
constexpr float EPS = 1e-6f;
constexpr long OY = 0, OCP = 33816576, OGP = 33835008, OHP = 33966080, OCS = 34228224, OGS = 34301952, OHS = 34826240;
constexpr size_t WS_P = 0;
constexpr size_t WS_WIN = WS_P + (size_t)T_ALL * NP * 2;
constexpr size_t WS_WOUT = WS_WIN + (size_t)NWT * DM * 2;
constexpr size_t WS_BA = WS_WOUT + (size_t)DM * DM * 2;
constexpr size_t WS_RSS = WS_BA + (size_t)T_ALL * 16 * 4;
constexpr size_t WS_GM = WS_RSS + (size_t)T_ALL * 16 * 4;
constexpr size_t WS_GN = WS_GM + (size_t)NUNIT * 8 * 8192;
constexpr size_t WS_GO = WS_GN + (size_t)NUNIT * 8 * 8192;
constexpr size_t WS_GS = WS_GO + (size_t)NUNIT * 8 * 8192;
constexpr size_t WS_HD = WS_GS + (size_t)NUNIT * 8 * 8192;
constexpr size_t WS_HDEC = WS_HD + (size_t)NUNIT * 4 * 32768;
constexpr size_t WS_BAR = WS_HDEC + (size_t)NUNIT * 4 * 128 * 4;
constexpr size_t WS_PART = WS_BAR + 16384;
constexpr size_t WS_END = WS_PART + (size_t)8 * 256 * 1024 * 4;
constexpr size_t DO_H = 0;
constexpr size_t DO_GQ = 0;
constexpr size_t DO_HQ = DO_GQ + (size_t)NUNIT * 8 * 8192;
constexpr size_t DO_HO = DO_HQ + (size_t)NUNIT * 4 * 16384;

struct Params {
  const float* x_prompt; const float* x_sample; const float* state_conv; const float* state_gdn; const float* state_hgrn;
  const float* norm_w; const float* w_in; const float* conv_w; const float* A_log; const float* dt_bias;
  const float* gdn_norm_w; const float* lb_logits; const float* hg_norm_w; const float* w_out; const float* final_norm_w;
  float* out; char* ws;
};

DI u32 pk2(float a, float b) { f32x2_t v = {a, b}; bf16x2_t r = __builtin_convertvector(v, bf16x2_t); return __builtin_bit_cast(u32, r); }
DI u16 f2b(float a) { return (u16)(pk2(a, 0.f) & 0xffffu); }
DI float b2f(u16 v) { return __uint_as_float(((u32)v) << 16); }
DI float rcpf_(float x) { return __builtin_amdgcn_rcpf(x); }
DI float sigmoidf_(float x) { return rcpf_(1.f + __expf(-x)); }
DI float siluf_(float x) { return x * rcpf_(1.f + __expf(-x)); }
DI const float* xrow(const Params& p, int r) { return r < T_P ? p.x_prompt + (size_t)r * DM : p.x_sample + (size_t)(r - T_P) * DM; }
DI bf16x8 ldfrag(const u16* base, int ld, int row0, int k0, int lane) {
  return *(const bf16x8*)(base + (size_t)(row0 + (lane & 15)) * ld + k0 + 8 * (lane >> 4));
}
DI int opaque_tid() { int t = threadIdx.x; asm volatile("" : "+v"(t)); return t; }
DI float4 ldnt4(const float* p) { f32x4 t = __builtin_nontemporal_load((const f32x4*)p); return make_float4(t[0], t[1], t[2], t[3]); }
DI f32x4 zero4() { f32x4 z = {0.f, 0.f, 0.f, 0.f}; return z; }

#define XB_TMO      128
#define XB_XCNT(j)  (256  + 64 * (j))
#define XB_XSUB(j)  (1280 + 64 * (j))
#define XB_XGEN(j)  (2304 + 64 * (j))
#define XB_TOP      3328
#define XB_TOPGEN   3392
#define XCD_BAR_WORDS 3456
#define XB_SPIN_CAP (1u << 18)
#define LAS __attribute__((address_space(3)))

__device__ __forceinline__ unsigned xb_ld(unsigned* p)              { return __hip_atomic_load(p, __ATOMIC_RELAXED, __HIP_MEMORY_SCOPE_AGENT); }
__device__ __forceinline__ unsigned xb_add(unsigned* p, unsigned v) { return __hip_atomic_fetch_add(p, v, __ATOMIC_RELAXED, __HIP_MEMORY_SCOPE_AGENT); }
__device__ __forceinline__ unsigned xb_xcc_id() { return (unsigned)__builtin_amdgcn_s_getreg((3 << 11) | 20) & 0xFu; }
#define XB_SPIN(cond, bar) do { unsigned _sp = 0; while (cond) { __builtin_amdgcn_s_sleep(1); \
    if ((++_sp & 255u) == 0u) { if (xb_ld(&(bar)[XB_TMO])) break; if (_sp > XB_SPIN_CAP) { atomicAdd(&(bar)[XB_TMO], 1u); break; } } } } while (0)

struct XcdBarrier {
    unsigned* bar; unsigned x;
    unsigned nloc, nx;
};

__device__ __forceinline__ XcdBarrier xcd_barrier_post(unsigned* bar) {
    XcdBarrier b; b.bar = bar; b.x = xb_xcc_id(); b.nloc = 0u; b.nx = 0u;
    if (threadIdx.x == 0) (void)xb_add(&bar[XB_XCNT(b.x)], 1u);
    return b;
}
__device__ __forceinline__ void xcd_barrier_complete(unsigned* bar, unsigned x, unsigned& nloc, unsigned& nx) {
    const unsigned G = gridDim.x * gridDim.y * gridDim.z;
    unsigned sum, cnt, mine, sp = 0u;
    for (;;) {
        sum = 0u; cnt = 0u; mine = 0u;
#pragma unroll
        for (unsigned j = 0; j < 16; ++j) { const unsigned c = xb_ld(&bar[XB_XCNT(j)]); sum += c; cnt += (c > 0u) ? 1u : 0u; mine = (j == x) ? c : mine; }
        if (sum == G) break;
        __builtin_amdgcn_s_sleep(1);
        if ((++sp & 255u) == 0u) { if (xb_ld(&bar[XB_TMO])) break; if (sp > XB_SPIN_CAP) { atomicAdd(&bar[XB_TMO], 1u); break; } }
    }
    nloc = mine > 0u ? mine : 1u; nx = cnt > 0u ? cnt : 1u;
}

__device__ __forceinline__ void xcd_barrier(XcdBarrier& b) {
    asm volatile("s_waitcnt vmcnt(0)" ::: "memory");
    __syncthreads();
    if (threadIdx.x == 0) {
        unsigned* bar = b.bar;
        __builtin_amdgcn_s_waitcnt(0);
        unsigned nloc = b.nloc, nx = b.nx;
        if (nloc == 0u) { xcd_barrier_complete(bar, b.x, nloc, nx); b.nloc = nloc; b.nx = nx; }
        const unsigned old = xb_add(&bar[XB_XSUB(b.x)], 1u);
        const unsigned gen = old / nloc;
        if (old + 1u == (gen + 1u) * nloc) {
            __builtin_amdgcn_fence(__ATOMIC_RELEASE, "agent");
            asm volatile("s_waitcnt vmcnt(0)" ::: "memory");
            const unsigned og = xb_add(&bar[XB_TOP], 1u);
            const unsigned tg = og / nx;
            if (og + 1u == (tg + 1u) * nx) xb_add(&bar[XB_TOPGEN], 1u);
            else XB_SPIN(xb_ld(&bar[XB_TOPGEN]) == tg, bar);
            __builtin_amdgcn_fence(__ATOMIC_ACQUIRE, "agent");
            xb_add(&bar[XB_XGEN(b.x)], 1u);
            asm volatile("s_waitcnt vmcnt(0)" ::: "memory");
        } else {
            XB_SPIN(xb_ld(&bar[XB_XGEN(b.x)]) == gen, bar);
            __builtin_amdgcn_fence(__ATOMIC_ACQUIRE, "agent");
            asm volatile("s_waitcnt vmcnt(0)" ::: "memory");
        }
    }
    __syncthreads();
}


static __device__ __forceinline__ void phase0(const Params& p, char* smem) {
  const int tid = opaque_tid(), lane = tid & 63, w = tid >> 6;
  u16* hbuf = (u16*)((char*)p.out + DO_H);
  u16* wtin = (u16*)(p.ws + WS_WIN);
  u16* wtout = (u16*)(p.ws + WS_WOUT);
  const int NT_RMS = T_ALL / 4, NT_WIN = (NWT / 64) * 16, NT_WOUT = 256;
  for (int task = blockIdx.x; task < NT_RMS + NT_WIN + NT_WOUT; task += gridDim.x) {
    if (task < NT_RMS) {
      int r = task * 4 + w;
      const float* xr = xrow(p, r);
      float4 v[4]; float ss = 0.f;
#pragma unroll
      for (int i = 0; i < 4; ++i) { v[i] = ldnt4(xr + i * 256 + lane * 4); ss += v[i].x * v[i].x + v[i].y * v[i].y + v[i].z * v[i].z + v[i].w * v[i].w; }
#pragma unroll
      for (int o = 32; o > 0; o >>= 1) ss += __shfl_xor(ss, o);
      float rs = rsqrtf(ss * (1.f / DM) + EPS);
#pragma unroll
      for (int i = 0; i < 4; ++i) {
        float4 nw = *(const float4*)(p.norm_w + i * 256 + lane * 4);
        uint2 o; o.x = pk2(v[i].x * rs * nw.x, v[i].y * rs * nw.y); o.y = pk2(v[i].z * rs * nw.z, v[i].w * rs * nw.w);
        *(uint2*)(hbuf + (size_t)r * DM + i * 256 + lane * 4) = o;
      }
    } else {
      float* tile = (float*)smem;
      int tt = task - NT_RMS; const float* src; u16* dst; int ldsrc, nt, kt; bool isin = tt < NT_WIN;
      if (isin) { nt = tt / 16; kt = tt % 16; src = p.w_in; ldsrc = 4112; dst = wtin; }
      else { tt -= NT_WIN; nt = tt / 16; kt = tt % 16; src = p.w_out; ldsrc = 1024; dst = wtout; }
      __syncthreads();
      for (int i = tid; i < 4096; i += 256) {
        int kk = i >> 6, nn = i & 63; int np_ = nt * 64 + nn; float val = 0.f;
        if (isin) {
          int orig = np_ < 2048 ? np_ : (np_ < 4096 ? np_ + 16 : (np_ < 4112 ? np_ - 2048 : -1));
          if (orig >= 0) val = src[(size_t)(kt * 64 + kk) * ldsrc + orig];
        } else val = src[(size_t)(kt * 64 + kk) * ldsrc + np_];
        tile[kk * 65 + nn] = val;
      }
      __syncthreads();
      for (int i = tid; i < 4096; i += 256) {
        int nn = i >> 6, kk = i & 63;
        dst[(size_t)(nt * 64 + nn) * DM + kt * 64 + kk] = f2b(tile[kk * 65 + nn]);
      }
    }
  }
}

DI int swz32(int row, int ch) { return row * 64 + ((ch ^ ((row >> 1) & 3)) << 4); }
struct GStg { u32x4 a[4], b[2]; };
DI void g_ld(GStg& r, const u16* ga, const u16* gb, int lda, int kt) {
#pragma unroll
  for (int i = 0; i < 4; ++i) r.a[i] = *(const u32x4*)(ga + (size_t)i * 64 * lda + kt * 32);
#pragma unroll
  for (int i = 0; i < 2; ++i) r.b[i] = *(const u32x4*)(gb + (size_t)i * 64 * DM + kt * 32);
}
DI void g_st(const GStg& r, char* buf, int srow, int sch) {
#pragma unroll
  for (int i = 0; i < 4; ++i) *(u32x4*)(buf + swz32(srow + i * 64, sch)) = r.a[i];
#pragma unroll
  for (int i = 0; i < 2; ++i) *(u32x4*)(buf + 16384 + swz32(srow + i * 64, sch)) = r.b[i];
}
DI void g_mma(const char* sa, f32x4 (&acc)[8][4], int wm, int wn, int l16, int q4) {
  const char* sb = sa + 16384;
  bf16x8 bfr[4], af[8];
#pragma unroll
  for (int j = 0; j < 4; ++j) bfr[j] = *(const bf16x8*)(sb + swz32(wn * 64 + j * 16 + l16, q4));
#pragma unroll
  for (int i = 0; i < 4; ++i) af[i] = *(const bf16x8*)(sa + swz32(wm * 128 + i * 16 + l16, q4));
  __builtin_amdgcn_sched_barrier(0);
#pragma unroll
  for (int i = 4; i < 8; ++i) af[i] = *(const bf16x8*)(sa + swz32(wm * 128 + i * 16 + l16, q4));
  __builtin_amdgcn_sched_barrier(0);
  __builtin_amdgcn_s_setprio(1);
#pragma unroll
  for (int i = 0; i < 4; ++i)
#pragma unroll
    for (int j = 0; j < 4; ++j) acc[i][j] = MFMA(bfr[j], af[i], acc[i][j]);
  __builtin_amdgcn_sched_barrier(0);
#pragma unroll
  for (int i = 4; i < 8; ++i)
#pragma unroll
    for (int j = 0; j < 4; ++j) acc[i][j] = MFMA(bfr[j], af[i], acc[i][j]);
  __builtin_amdgcn_s_setprio(0);
}

#define EPI_BARRIER() do { asm volatile("s_waitcnt lgkmcnt(0)" ::: "memory"); __builtin_amdgcn_s_barrier(); } while (0)
static __device__ __forceinline__ void gemm_tile(const u16* __restrict__ A, int lda, const u16* __restrict__ Bt, int m0, int n0, int k0, int nk, char* smem, f32x4 (&acc)[8][4],
                                                 bool pre_issued = false, bool has_next = false, int nm0 = 0, int nn0 = 0) {
  const int tid = opaque_tid(), lane = tid & 63, w = tid >> 6, wm = w >> 1, wn = w & 1, l16 = lane & 15, q4 = lane >> 4;
#pragma unroll
  for (int i = 0; i < 8; ++i)
#pragma unroll
    for (int j = 0; j < 4; ++j) acc[i][j] = zero4();
  const int srow = tid >> 2, ch = (tid & 3) ^ ((srow >> 1) & 3);
  const u16* ga = A + (size_t)(m0 + srow) * lda + ch * 8 + k0;
  const u16* gb = Bt + (size_t)(n0 + srow) * DM + ch * 8 + k0;
  char* lds_t = smem + tid * 16;
#define GEMM_ISSUE(GA, GB, BUF, KT) do { \
    _Pragma("unroll") for (int i_ = 0; i_ < 4; ++i_) \
      __builtin_amdgcn_global_load_lds((const unsigned*)((GA) + (size_t)i_ * 64 * lda + (KT) * 32), (unsigned*)(lds_t + (BUF) + i_ * 4096), 16, 0, 0); \
    _Pragma("unroll") for (int i_ = 0; i_ < 2; ++i_) \
      __builtin_amdgcn_global_load_lds((const unsigned*)((GB) + (size_t)i_ * 64 * DM + (KT) * 32), (unsigned*)(lds_t + (BUF) + 16384 + i_ * 4096), 16, 0, 0); \
  } while (0)
  if (!pre_issued) {
    __syncthreads();
    GEMM_ISSUE(ga, gb, 0, 0);
  }
  __syncthreads();
  for (int kt = 0; kt < nk; ++kt) {
    const int cur = (kt & 1) * 24576, nxt = ((kt + 1) & 1) * 24576;
    if (kt + 1 < nk) GEMM_ISSUE(ga, gb, nxt, kt + 1);
    __builtin_amdgcn_sched_barrier(0);
    g_mma(smem + cur, acc, wm, wn, l16, q4);
    __syncthreads();
  }
  if (has_next) {
    const u16* ga2 = A + (size_t)(nm0 + srow) * lda + ch * 8 + k0;
    const u16* gb2 = Bt + (size_t)(nn0 + srow) * DM + ch * 8 + k0;
    GEMM_ISSUE(ga2, gb2, 0, 0);
  }
#undef GEMM_ISSUE
}

static __device__ __forceinline__ void p1_tile(const Params& p, char* smem, int mt, int nt, bool pre_issued = false, bool has_next = false, int nmt = 0, int nnt = 0) {
  const int tid = opaque_tid(), lane = tid & 63, w = tid >> 6, wm = w >> 1, wn = w & 1, l16 = lane & 15, q4 = lane >> 4;
  const u16* hbuf = (const u16*)((char*)p.out + DO_H);
  const u16* wtin = (const u16*)(p.ws + WS_WIN);
  u16* P = (u16*)(p.ws + WS_P);
  float* ba = (float*)(p.ws + WS_BA);
  u16* stg = (u16*)(smem + 24576);
  f32x4 acc[8][4];
  gemm_tile(hbuf, DM, wtin, mt * 256, nt * 128, 0, 32, smem, acc, pre_issued, has_next, nmt * 256, nnt * 128);
  if (nt == 32) {
    if (wn == 0) {
#pragma unroll
      for (int mi = 0; mi < 8; ++mi) {
        int row = mt * 256 + wm * 128 + mi * 16 + l16;
        *(float4*)(ba + (size_t)row * 16 + 4 * q4) = make_float4(acc[mi][0][0], acc[mi][0][1], acc[mi][0][2], acc[mi][0][3]);
      }
    }
    return;
  }
  const bool convtile = nt < 12 && (mt == 128 || (mt & 31) == 31);
  if (convtile) {
#pragma unroll
    for (int mi = 0; mi < 8; ++mi)
#pragma unroll
      for (int ni = 0; ni < 4; ++ni)
#pragma unroll
        for (int i = 0; i < 4; ++i) {
          int row = mt * 256 + wm * 128 + mi * 16 + l16, col = nt * 128 + wn * 64 + ni * 16 + q4 * 4 + i;
          float v = acc[mi][ni][i];
          if (row < T_P) { int tt = row & 8191; if (tt >= 8189) p.out[OCP + ((size_t)(row >> 13) * 3 + (tt - 8189)) * 1536 + col] = v; }
          else { int rr = row - T_P, tt = rr & 15; if (tt >= 13) p.out[OCS + ((size_t)(rr >> 4) * 3 + (tt - 13)) * 1536 + col] = v; }
        }
  }
#pragma unroll
  for (int hh = 0; hh < 2; ++hh) {
    if (wm == hh) {
#pragma unroll
      for (int mi = 0; mi < 8; ++mi)
#pragma unroll
        for (int ni = 0; ni < 4; ++ni)
          *(uint2*)(stg + (mi * 16 + l16) * 136 + wn * 64 + ni * 16 + q4 * 4) = make_uint2(pk2(acc[mi][ni][0], acc[mi][ni][1]), pk2(acc[mi][ni][2], acc[mi][ni][3]));
    }
    EPI_BARRIER();
#pragma unroll
    for (int k = 0; k < 8; ++k) {
      int id = tid + 256 * k, row = id >> 4, cc = id & 15;
      __builtin_nontemporal_store(*(const u32x4*)(stg + row * 136 + cc * 8), (u32x4*)(P + (size_t)(mt * 256 + hh * 128 + row) * NP + nt * 128 + cc * 8));
    }
    EPI_BARRIER();
  }
}

static __device__ __forceinline__ void phase1(const Params& p, char* smem) {
  const int G = gridDim.x;
  int x = blockIdx.x & 7, j = blockIdx.x >> 3, nj = (G + 7 - x) / 8;
  int nxcd = G < 8 ? G : 8;
  if (G < 8) { x = blockIdx.x; j = 0; nj = 1; }
  {
    int s = x, r = j; bool pre = false;
    while (s < 64 && r < 64) {
      int ns = s, nr = r + nj;
      if (nr >= 64) { ns = s + nxcd; nr = j; }
      const bool hn = ns < 64 && nr < 64;
      p1_tile(p, smem, (s >> 2) * 8 + (r & 7), (s & 3) * 8 + (r >> 3), pre, hn, (ns >> 2) * 8 + (nr & 7), (ns & 3) * 8 + (nr >> 3));
      pre = hn; s = ns; r = nr;
    }
  }
  for (int t = blockIdx.x; t < 32 + 129; t += G) {
    if (t < 32) p1_tile(p, smem, 128, t);
    else p1_tile(p, smem, t - 32, 32);
  }
}

DI int slotG(int unit, int h) { return unit < 512 ? (((unit >> 7) * 8 + h) * 128 + (unit & 127)) : (4096 + (unit - 512) * 8 + h); }
DI int slotH(int unit, int h) { return unit < 512 ? (((unit >> 7) * 4 + h) * 128 + (unit & 127)) : (2048 + (unit - 512) * 4 + h); }

struct GPre { u32x4 rg[7]; float bval, gval, alog, dtb; float2 cw[12]; float2 sc[9]; };

DI void gdn_prefetch(GPre& pre, const Params& p, int unit, int h, int tid) {
  const u16* P = (const u16*)(p.ws + WS_P);
  const float* ba = (const float*)(p.ws + WS_BA);
  const bool sample = unit >= 512;
  const int t0 = sample ? T_P + (unit - 512) * 16 : unit * 64;
  const int nv = sample ? 16 : 64;
  const int cseq = sample ? 0 : (unit & 127);
  const int lane = tid & 63, w = tid >> 6;
#pragma unroll
  for (int k = 0; k < 7; ++k) {
    const int id = tid + 256 * k;
    const int seg = id / 536, rem = id - seg * 536, row = rem >> 3, ch = rem & 7, r = row - 3;
    const bool ok = id < 1608 && (r >= 0 ? (r < nv) : (!sample && cseq > 0));
    u32x4 v = {0u, 0u, 0u, 0u};
    if (ok) v = __builtin_nontemporal_load((const u32x4*)(P + (size_t)(t0 + r) * NP + seg * 512 + h * 64 + ch * 8));
    pre.rg[k] = v;
  }
  pre.bval = 0.f; pre.gval = 0.f;
  if (tid < 64 && tid < nv) { pre.bval = ba[(size_t)(t0 + tid) * 16 + h]; pre.gval = ba[(size_t)(t0 + tid) * 16 + 8 + h]; }
  pre.alog = p.A_log[h]; pre.dtb = p.dt_bias[h];
#pragma unroll
  for (int s3 = 0; s3 < 3; ++s3) {
    const int col = s3 * 512 + h * 64 + (lane & 31) * 2;
#pragma unroll
    for (int jj = 0; jj < 4; ++jj) pre.cw[s3 * 4 + jj] = *(const float2*)(p.conv_w + jj * 1536 + col);
#pragma unroll
    for (int jj = 0; jj < 3; ++jj) {
      float2 v = make_float2(0.f, 0.f);
      if (sample && w == 0 && lane < 32) v = *(const float2*)(p.state_conv + ((size_t)(unit - 512) * 3 + jj) * 1536 + col);
      pre.sc[s3 * 3 + jj] = v;
    }
  }
}

static __device__ __forceinline__ void gdn_prep(const Params& p, int unit, int h, char* smem, GPre& pre, int nunit, int nh, bool hasnext) {
  const int tid = opaque_tid(), lane = tid & 63, w = tid >> 6, l16 = lane & 15, q4 = lane >> 4;
  const bool sample = unit >= 512;
  const int nv = sample ? 16 : 64;
  const int slot = slotG(unit, h);
  u16* qb = (u16*)smem;
  u16* kb = qb + 64 * 72;
  u16* vb = kb + 64 * 72;
  u16* kdT = vb;
  u16* wT = vb + 64 * 72;
  u16* uT = wT + 64 * 72;
  u16* Lb = uT + 64 * 72;
  u16* attn = Lb;
  float* Ld = (float*)(Lb + 64 * 72);
  u16* Tinv = (u16*)(Ld + 1024);
  float* s_gcum = (float*)(Tinv + 1024);
  float* s_beta = s_gcum + 64;
  float* s_rnk = s_beta + 64;
  float* s_rnq = s_rnk + 64;

  __syncthreads();
  u16* raw = wT;
#pragma unroll
  for (int k = 0; k < 7; ++k) {
    const int id = tid + 256 * k;
    if (id < 1608) *(u32x4*)(raw + id * 8) = pre.rg[k];
  }
  const float bval = pre.bval, gval = pre.gval, alog = pre.alog, dtb = pre.dtb;
  float2 cw[12], sc[9];
#pragma unroll
  for (int k = 0; k < 12; ++k) cw[k] = pre.cw[k];
#pragma unroll
  for (int k = 0; k < 9; ++k) sc[k] = pre.sc[k];
  if (hasnext) gdn_prefetch(pre, p, nunit, nh, tid);
  __syncthreads();
  {
    const int c2 = (lane & 31) * 2, tg8 = w * 2 + (lane >> 5);
#pragma unroll
    for (int s3 = 0; s3 < 3; ++s3) {
      float wa[4], wb[4];
#pragma unroll
      for (int jj = 0; jj < 4; ++jj) { wa[jj] = cw[s3 * 4 + jj].x; wb[jj] = cw[s3 * 4 + jj].y; }
      const u16* rs = raw + s3 * (67 * 64) + c2;
      float a3, a2, a1, b3, b2, b1;
      {
        const u32 h3 = *(const u32*)(rs + (tg8 * 8 + 0) * 64), h2 = *(const u32*)(rs + (tg8 * 8 + 1) * 64), h1 = *(const u32*)(rs + (tg8 * 8 + 2) * 64);
        const bool us = sample && tg8 == 0;
        a3 = us ? sc[s3 * 3].x : __uint_as_float(h3 << 16); b3 = us ? sc[s3 * 3].y : __uint_as_float(h3 & 0xffff0000u);
        a2 = us ? sc[s3 * 3 + 1].x : __uint_as_float(h2 << 16); b2 = us ? sc[s3 * 3 + 1].y : __uint_as_float(h2 & 0xffff0000u);
        a1 = us ? sc[s3 * 3 + 2].x : __uint_as_float(h1 << 16); b1 = us ? sc[s3 * 3 + 2].y : __uint_as_float(h1 & 0xffff0000u);
      }
      u16* dstb = s3 == 0 ? qb : (s3 == 1 ? kb : vb);
#pragma unroll
      for (int i = 0; i < 8; ++i) {
        const int tt = tg8 * 8 + i;
        float a0 = 0.f, b0 = 0.f;
        if (tt < nv) { u32 x = *(const u32*)(rs + (tt + 3) * 64); a0 = __uint_as_float(x << 16); b0 = __uint_as_float(x & 0xffff0000u); }
        float oa = wa[0] * a3 + wa[1] * a2 + wa[2] * a1 + wa[3] * a0;
        float ob = wb[0] * b3 + wb[1] * b2 + wb[2] * b1 + wb[3] * b0;
        oa = tt < nv ? siluf_(oa) : 0.f; ob = tt < nv ? siluf_(ob) : 0.f;
        *(u32*)(dstb + tt * 72 + c2) = pk2(oa, ob);
        a3 = a2; a2 = a1; a1 = a0; b3 = b2; b2 = b1; b1 = b0;
      }
    }
    if (tid < 64) {
      int tt = tid; float g = 0.f, be = 0.f;
      if (tt < nv) {
        be = sigmoidf_(bval);
        float xx = gval + dtb;
        float sp = fmaxf(xx, 0.f) + log1pf(__expf(-fabsf(xx)));
        g = -__expf(alog) * sp;
      }
#pragma unroll
      for (int o = 1; o < 64; o <<= 1) { float t = __shfl_up(g, o); if (lane >= o) g += t; }
      s_gcum[tt] = g; s_beta[tt] = be;
    }
  }
  __syncthreads();
  for (int i = tid; i < 2 * 64 * 72 / 8; i += 256) ((uint4*)wT)[i] = make_uint4(0, 0, 0, 0);
  f32x4 kk[4];
  {
    f32x4 qq = zero4();
#pragma unroll
    for (int ni = 0; ni < 4; ++ni) kk[ni] = zero4();
#pragma unroll
    for (int s = 0; s < 2; ++s) {
      bf16x8 a = ldfrag(kb, 72, 16 * w, 32 * s, lane);
#pragma unroll
      for (int ni = 0; ni < 4; ++ni) { bf16x8 b = ldfrag(kb, 72, 16 * ni, 32 * s, lane); kk[ni] = MFMA(a, b, kk[ni]); }
      bf16x8 aq = ldfrag(qb, 72, 16 * w, 32 * s, lane);
      qq = MFMA(aq, aq, qq);
    }
    if (q4 == (l16 >> 2)) {
      int ii = l16 & 3;
      f32x4 kd = w == 0 ? kk[0] : (w == 1 ? kk[1] : (w == 2 ? kk[2] : kk[3]));
      float dk_ = ii == 0 ? kd[0] : (ii == 1 ? kd[1] : (ii == 2 ? kd[2] : kd[3]));
      float dq_ = ii == 0 ? qq[0] : (ii == 1 ? qq[1] : (ii == 2 ? qq[2] : qq[3]));
      s_rnk[16 * w + l16] = rsqrtf(dk_ + EPS);
      s_rnq[16 * w + l16] = rsqrtf(dq_ + EPS) * 0.125f;
    }
  }
  __syncthreads();
  const float glast = s_gcum[63];
  float r_gc[4], r_brn[4], r_rnq[4], c_gc[4], c_rnk[4];
#pragma unroll
  for (int i = 0; i < 4; ++i) {
    const int row = 16 * w + 4 * q4 + i;
    r_gc[i] = s_gcum[row]; r_brn[i] = s_beta[row] * s_rnk[row]; r_rnq[i] = s_rnq[row];
    const int col = 16 * i + l16;
    c_gc[i] = s_gcum[col]; c_rnk[i] = s_rnk[col];
  }
#pragma unroll
  for (int ni = 0; ni < 4; ++ni)
#pragma unroll
    for (int i = 0; i < 4; ++i) {
      int row = 16 * w + 4 * q4 + i, col = 16 * ni + l16;
      float v = 0.f;
      if (row > col) v = r_brn[i] * c_rnk[ni] * kk[ni][i] * __expf(r_gc[i] - c_gc[ni]);
      Lb[row * 72 + col] = f2b(-v);
      if (ni == w) Ld[(w * 16 + 4 * q4 + i) * 16 + l16] = v;
    }
  __syncthreads();
  if (tid < 64) {
    const int blk = tid >> 4, j = tid & 15;
    const float* L = Ld + blk * 256;
    float X[16];
#pragma unroll
    for (int i = 0; i < 16; ++i) X[i] = (i == j) ? 1.f : 0.f;
#pragma unroll
    for (int i = 1; i < 16; ++i) {
      float a = X[i];
#pragma unroll
      for (int k = 0; k < i; ++k) a -= L[i * 16 + k] * X[k];
      X[i] = a;
    }
#pragma unroll
    for (int i = 0; i < 16; ++i) Tinv[(blk * 16 + i) * 16 + j] = f2b(X[i]);
  }
  __syncthreads();
  {
    u16* XT = w < 2 ? uT : wT;
    const u16* src = w < 2 ? vb : kb;
    f32x4 racc[4][2];
#pragma unroll
    for (int blk = 0; blk < 4; ++blk) {
      const float4 be4 = *(const float4*)(s_beta + 16 * blk + 4 * q4);
      float sc4[4] = {be4.x, be4.y, be4.z, be4.w};
      if (w >= 2) {
        const float4 rk = *(const float4*)(s_rnk + 16 * blk + 4 * q4), gc = *(const float4*)(s_gcum + 16 * blk + 4 * q4);
        sc4[0] *= rk.x * __expf(gc.x); sc4[1] *= rk.y * __expf(gc.y); sc4[2] *= rk.z * __expf(gc.z); sc4[3] *= rk.w * __expf(gc.w);
      }
#pragma unroll
      for (int tI = 0; tI < 2; ++tI) {
        const int cl = (w & 1) * 32 + tI * 16;
#pragma unroll
        for (int i = 0; i < 4; ++i) racc[blk][tI][i] = b2f(src[(16 * blk + 4 * q4 + i) * 72 + cl + l16]) * sc4[i];
      }
    }
#pragma unroll
    for (int blk = 0; blk < 4; ++blk) {
#pragma unroll
      for (int tI = 0; tI < 2; ++tI) {
        const int cl = (w & 1) * 32 + tI * 16;
        f32x4 acc = racc[blk][tI];
        if (blk > 0) {
#pragma unroll
          for (int s = 0; s < (blk + 1) / 2; ++s) {
            bf16x8 a = ldfrag(Lb, 72, 16 * blk, 32 * s, lane);
            if ((blk & 1) && s == (blk - 1) / 2 && q4 >= 2) a = (bf16x8){0, 0, 0, 0, 0, 0, 0, 0};
            bf16x8 b = ldfrag(XT, 72, cl, 32 * s, lane);
            acc = MFMA(a, b, acc);
          }
        }
        uint2 tv = *(const uint2*)(Tinv + (blk * 16 + l16) * 16 + 4 * q4);
        bf16x8 at = __builtin_bit_cast(bf16x8, make_uint4(tv.x, tv.y, 0u, 0u));
        bf16x8 by = __builtin_bit_cast(bf16x8, make_uint4(pk2(acc[0], acc[1]), pk2(acc[2], acc[3]), 0u, 0u));
        f32x4 xt = MFMA(at, by, zero4());
        *(uint2*)(XT + (cl + l16) * 72 + 16 * blk + 4 * q4) = make_uint2(pk2(xt[0], xt[1]), pk2(xt[2], xt[3]));
      }
    }
  }
  __syncthreads();
  {
    const int d = lane, tg = w;
    u32 pk[8];
    float tsc[16];
#pragma unroll
    for (int i = 0; i < 16; i += 4) {
      const float4 rk = *(const float4*)(s_rnk + tg * 16 + i), gc = *(const float4*)(s_gcum + tg * 16 + i);
      tsc[i] = rk.x * __expf(glast - gc.x); tsc[i + 1] = rk.y * __expf(glast - gc.y);
      tsc[i + 2] = rk.z * __expf(glast - gc.z); tsc[i + 3] = rk.w * __expf(glast - gc.w);
    }
#pragma unroll
    for (int i = 0; i < 16; i += 2) {
      int ta = tg * 16 + i, tb = ta + 1;
      float va = b2f(kb[ta * 72 + d]) * tsc[i];
      float vb_ = b2f(kb[tb * 72 + d]) * tsc[i + 1];
      pk[i >> 1] = pk2(va, vb_);
    }
    uint4* dst = (uint4*)(kdT + d * 72 + tg * 16);
    dst[0] = make_uint4(pk[0], pk[1], pk[2], pk[3]); dst[1] = make_uint4(pk[4], pk[5], pk[6], pk[7]);
  }
  {
    f32x4 qk[4];
#pragma unroll
    for (int ni = 0; ni < 4; ++ni) qk[ni] = zero4();
#pragma unroll
    for (int s = 0; s < 2; ++s) {
      bf16x8 a = ldfrag(qb, 72, 16 * w, 32 * s, lane);
#pragma unroll
      for (int ni = 0; ni < 4; ++ni) { bf16x8 b = ldfrag(kb, 72, 16 * ni, 32 * s, lane); qk[ni] = MFMA(a, b, qk[ni]); }
    }
#pragma unroll
    for (int ni = 0; ni < 4; ++ni)
#pragma unroll
      for (int i = 0; i < 4; ++i) {
        int row = 16 * w + 4 * q4 + i, col = 16 * ni + l16;
        float v = 0.f;
        if (row >= col) v = qk[ni][i] * r_rnq[i] * c_rnk[ni] * __expf(r_gc[i] - c_gc[ni]);
        attn[row * 72 + col] = f2b(v);
      }
  }
  __syncthreads();
  {
    u16* gM = (u16*)(p.ws + WS_GM) + (size_t)slot * 4096;
    u16* gN = (u16*)(p.ws + WS_GN) + (size_t)slot * 4096;
    u16* gO = (u16*)(p.ws + WS_GO) + (size_t)slot * 4096;
    u16* gQ = (u16*)((char*)p.out + DO_GQ) + (size_t)slot * 4096;
    f32x4 aM[4], aN[4], aW[4], aU[4];
#pragma unroll
    for (int ni = 0; ni < 4; ++ni) { aM[ni] = zero4(); aN[ni] = zero4(); aW[ni] = zero4(); aU[ni] = zero4(); }
#pragma unroll
    for (int s = 0; s < 2; ++s) {
      bf16x8 akd = ldfrag(kdT, 72, 16 * w, 32 * s, lane);
      bf16x8 aat = ldfrag(attn, 72, 16 * w, 32 * s, lane);
#pragma unroll
      for (int ni = 0; ni < 4; ++ni) {
        bf16x8 bw = ldfrag(wT, 72, 16 * ni, 32 * s, lane);
        bf16x8 bu = ldfrag(uT, 72, 16 * ni, 32 * s, lane);
        aM[ni] = MFMA(akd, bw, aM[ni]); aN[ni] = MFMA(akd, bu, aN[ni]);
        aW[ni] = MFMA(aat, bw, aW[ni]); aU[ni] = MFMA(aat, bu, aU[ni]);
      }
    }
    const float eg = __expf(glast);
#pragma unroll
    for (int ni = 0; ni < 4; ++ni) {
#pragma unroll
      for (int i = 0; i < 4; ++i) {
        int row = 16 * w + 4 * q4 + i, col = 16 * ni + l16;
        gM[row * 64 + col] = f2b((row == col ? eg : 0.f) - aM[ni][i]);
        float qv = b2f(qb[row * 72 + col]) * r_rnq[i] * __expf(r_gc[i]);
        gQ[row * 64 + col] = f2b(qv - aW[ni][i]);
      }
      *(uint2*)(gN + ((w * 64 + lane) * 4 + ni) * 4) = make_uint2(pk2(aN[ni][0], aN[ni][1]), pk2(aN[ni][2], aN[ni][3]));
      *(uint2*)(gO + ((w * 4 + ni) * 64 + lane) * 4) = make_uint2(pk2(aU[ni][0], aU[ni][1]), pk2(aU[ni][2], aU[ni][3]));
    }
  }
}

struct HPre { u32x4 rq[4], rf[4], rv[4]; float l0, l1; };
DI void hg_prefetch(HPre& pre, const Params& p, int unit, int h, int tid) {
  const u16* P = (const u16*)(p.ws + WS_P);
  const bool sample = unit >= 512;
  const int t0 = sample ? T_P + (unit - 512) * 16 : unit * 64;
  const int nv = sample ? 16 : 64;
#pragma unroll
  for (int k = 0; k < 4; ++k) {
    const int id = tid + 256 * k, row = id >> 4, cc = id & 15;
    u32x4 z = {0u, 0u, 0u, 0u};
    pre.rq[k] = z; pre.rf[k] = z; pre.rv[k] = z;
    if (row < nv) {
      const u16* pr = P + (size_t)(t0 + row) * NP + h * 128 + cc * 8;
      pre.rq[k] = __builtin_nontemporal_load((const u32x4*)(pr + PHQ)); pre.rf[k] = __builtin_nontemporal_load((const u32x4*)(pr + PHF)); pre.rv[k] = __builtin_nontemporal_load((const u32x4*)(pr + PHI));
    }
  }
  const int dg = h * 128 + (tid & 127);
  pre.l0 = p.lb_logits[dg]; pre.l1 = p.lb_logits[512 + dg];
}

static __device__ __forceinline__ void hg_prep(const Params& p, int unit, int h, char* smem, HPre& pre, int nunit, int nh, bool hasnext) {
  const int tid = opaque_tid(), lane = tid & 63, w = tid >> 6, l16 = lane & 15, q4 = lane >> 4;
  const bool sample = unit >= 512;
  const int nv = sample ? 16 : 64;
  const int slot = slotH(unit, h);
  u16* qt = (u16*)smem;
  u16* kt = (u16*)(smem + 18432);
  u16* vT = (u16*)(smem + 35840);
  u16* attn = (u16*)(smem + 54272);
  u16* kdT = (u16*)smem;
  float ebl = 0.f;
  __syncthreads();
#pragma unroll
  for (int k = 0; k < 4; ++k) {
    const int id = tid + 256 * k, row = id >> 4, cc = id & 15;
    *(u32x4*)(qt + row * 136 + cc * 8) = pre.rq[k];
    *(u32x4*)(kt + row * 136 + cc * 8) = pre.rf[k];
#pragma unroll
    for (int j = 0; j < 4; ++j) {
      vT[(cc * 8 + 2 * j) * 72 + row] = (u16)(pre.rv[k][j] & 0xffffu);
      vT[(cc * 8 + 2 * j + 1) * 72 + row] = (u16)(pre.rv[k][j] >> 16);
    }
  }
  const float lbv = sigmoidf_(pre.l0 - pre.l1);
  if (hasnext) hg_prefetch(pre, p, nunit, nh, tid);
  __syncthreads();
  if (tid < 128) {
    const int d = tid;
    const float lb = lbv;
    float b = 1.f;
#pragma unroll 4
    for (int t = 0; t < 64; ++t) {
      float qv = 0.f, kv = 0.f;
      if (t < nv) {
        float xx = b2f(kt[t * 136 + d]);
        float xq = b2f(qt[t * 136 + d]);
        float sg = sigmoidf_(xx);
        float f = lb + (1.f - lb) * sg;
        float omf = (1.f - lb) * (1.f - sg);
        b *= f;
        qv = siluf_(xq) * b; kv = omf * rcpf_(b);
      }
      qt[t * 136 + d] = f2b(qv); kt[t * 136 + d] = f2b(kv);
    }
    ebl = b;
    ((float*)(p.ws + WS_HDEC))[(size_t)slot * 128 + d] = ebl;
  }
  __syncthreads();
  f32x4 at[4];
#pragma unroll
  for (int ni = 0; ni < 4; ++ni) at[ni] = zero4();
#pragma unroll
  for (int s = 0; s < 4; ++s) {
    bf16x8 a = ldfrag(qt, 136, 16 * w, 32 * s, lane);
#pragma unroll
    for (int ni = 0; ni < 4; ++ni) { bf16x8 b = ldfrag(kt, 136, 16 * ni, 32 * s, lane); at[ni] = MFMA(a, b, at[ni]); }
  }
#pragma unroll
  for (int ni = 0; ni < 4; ++ni)
#pragma unroll
    for (int i = 0; i < 4; ++i) {
      int row = 16 * w + 4 * q4 + i, col = 16 * ni + l16;
      attn[row * 72 + col] = f2b(row >= col ? at[ni][i] : 0.f);
    }
  {
    u16* gq = (u16*)((char*)p.out + DO_HQ) + (size_t)slot * 8192;
#pragma unroll
    for (int k = 0; k < 4; ++k) {
      int id = tid + 256 * k, row = id >> 4, cc = id & 15;
      *(uint4*)(gq + row * 128 + cc * 8) = *(const uint4*)(qt + row * 136 + cc * 8);
    }
  }
  __syncthreads();
  if (tid < 128) {
    const int d = tid;
#pragma unroll 2
    for (int t = 0; t < 64; t += 8) {
      float kv[8];
#pragma unroll
      for (int k = 0; k < 8; ++k) kv[k] = b2f(kt[(t + k) * 136 + d]) * ebl;
      *(uint4*)(kdT + d * 72 + t) = make_uint4(pk2(kv[0], kv[1]), pk2(kv[2], kv[3]), pk2(kv[4], kv[5]), pk2(kv[6], kv[7]));
    }
  }
  __syncthreads();
  {
    u16* hD = (u16*)(p.ws + WS_HD) + (size_t)slot * 16384;
    u16* gOh = (u16*)((char*)p.out + DO_HO) + (size_t)slot * 8192;
#pragma unroll
    for (int mi = 0; mi < 2; ++mi) {
      f32x4 acc[8];
#pragma unroll
      for (int ni = 0; ni < 8; ++ni) acc[ni] = zero4();
#pragma unroll
      for (int s = 0; s < 2; ++s) {
        bf16x8 a = ldfrag(vT, 72, 32 * w + 16 * mi, 32 * s, lane);
#pragma unroll
        for (int ni = 0; ni < 8; ++ni) { bf16x8 b = ldfrag(kdT, 72, 16 * ni, 32 * s, lane); acc[ni] = MFMA(b, a, acc[ni]); }
      }
#pragma unroll
      for (int ni = 0; ni < 8; ++ni) {
        const int e = 32 * w + 16 * mi + l16, d = 16 * ni + 4 * q4;
        *(uint2*)(hD + e * 128 + d) = make_uint2(pk2(acc[ni][0], acc[ni][1]), pk2(acc[ni][2], acc[ni][3]));
      }
    }
    f32x4 ao[8];
#pragma unroll
    for (int ni = 0; ni < 8; ++ni) ao[ni] = zero4();
#pragma unroll
    for (int s = 0; s < 2; ++s) {
      bf16x8 a = ldfrag(attn, 72, 16 * w, 32 * s, lane);
#pragma unroll
      for (int ni = 0; ni < 8; ++ni) { bf16x8 b = ldfrag(vT, 72, 16 * ni, 32 * s, lane); ao[ni] = MFMA(a, b, ao[ni]); }
    }
#pragma unroll
    for (int ni = 0; ni < 8; ++ni)
      *(uint2*)(gOh + ((w * 8 + ni) * 64 + lane) * 4) = make_uint2(pk2(ao[ni][0], ao[ni][1]), pk2(ao[ni][2], ao[ni][3]));
  }
}

static __device__ __forceinline__ void phase2a(const Params& p, char* smem) {
  const int G = gridDim.x;
  GPre pre;
  if ((int)blockIdx.x < NUNIT * 8) gdn_prefetch(pre, p, blockIdx.x >> 3, blockIdx.x & 7, opaque_tid());
  for (int it = blockIdx.x; it < NUNIT * 8; it += G) {
    const int nx = it + G;
    gdn_prep(p, it >> 3, it & 7, smem, pre, nx >> 3, nx & 7, nx < NUNIT * 8);
  }
}

struct GStage { uint4 a[2]; uint4 n[2]; };

DI void gdn_load(GStage& st, const u16* gM, const u16* gN, int slot, int w, int lane) {
  const int l16 = lane & 15, q4 = lane >> 4;
  const u16* m = gM + (size_t)slot * 4096 + (16 * w + l16) * 64 + 8 * q4;
  st.a[0] = *(const uint4*)(m); st.a[1] = *(const uint4*)(m + 32);
  const u16* n = gN + (size_t)slot * 4096 + (w * 64 + lane) * 16;
  st.n[0] = *(const uint4*)(n); st.n[1] = *(const uint4*)(n + 8);
}

DI void gdn_step(f32x4 (&S)[4], const GStage& st, u16* gS, int slot, int w, int lane, u16* ST) {
  const int l16 = lane & 15, q4 = lane >> 4;
  uint2 sp[4];
#pragma unroll
  for (int ni = 0; ni < 4; ++ni) {
    sp[ni] = make_uint2(pk2(S[ni][0], S[ni][1]), pk2(S[ni][2], S[ni][3]));
    *(uint2*)(ST + (16 * ni + l16) * 72 + 16 * w + 4 * q4) = sp[ni];
  }
  u16* dst = gS + (size_t)slot * 4096 + (w * 64 + lane) * 16;
  *(uint4*)(dst) = make_uint4(sp[0].x, sp[0].y, sp[1].x, sp[1].y);
  *(uint4*)(dst + 8) = make_uint4(sp[2].x, sp[2].y, sp[3].x, sp[3].y);
  __syncthreads();
  bf16x8 a0 = __builtin_bit_cast(bf16x8, st.a[0]), a1 = __builtin_bit_cast(bf16x8, st.a[1]);
  const u32 nn[8] = {st.n[0].x, st.n[0].y, st.n[0].z, st.n[0].w, st.n[1].x, st.n[1].y, st.n[1].z, st.n[1].w};
#pragma unroll
  for (int ni = 0; ni < 4; ++ni) {
    f32x4 acc;
    acc[0] = __uint_as_float(nn[2 * ni] << 16); acc[1] = __uint_as_float(nn[2 * ni] & 0xffff0000u);
    acc[2] = __uint_as_float(nn[2 * ni + 1] << 16); acc[3] = __uint_as_float(nn[2 * ni + 1] & 0xffff0000u);
    bf16x8 b0 = ldfrag(ST, 72, 16 * ni, 0, lane);
    bf16x8 b1 = ldfrag(ST, 72, 16 * ni, 32, lane);
    acc = MFMA(a0, b0, acc);
    acc = MFMA(a1, b1, acc);
    S[ni] = acc;
  }
}

static __device__ __forceinline__ void gdn_scan_wg(const Params& p, int task, char* smem) {
  const int tid = opaque_tid(), lane = tid & 63, w = tid >> 6, l16 = lane & 15, q4 = lane >> 4;
  const u16* gM = (const u16*)(p.ws + WS_GM);
  const u16* gN = (const u16*)(p.ws + WS_GN);
  u16* gS = (u16*)(p.ws + WS_GS);
  u16* ST0 = (u16*)smem; u16* ST1 = ST0 + 64 * 72;
  f32x4 S[4];
  __syncthreads();
  if (task < 32) {
    const int base = task * 128;
#pragma unroll
    for (int ni = 0; ni < 4; ++ni) S[ni] = zero4();
    GStage st[10];
#pragma unroll
    for (int k = 0; k < 10; ++k) gdn_load(st[k], gM, gN, base + k, w, lane);
    for (int c0 = 0; c0 < 130; c0 += 10) {
#pragma unroll
      for (int k = 0; k < 10; ++k) {
        const int c = c0 + k;
        if (c < 128) {
          gdn_step(S, st[k], gS, base + c, w, lane, (k & 1) ? ST1 : ST0);
          if (c + 10 < 128) gdn_load(st[k], gM, gN, base + c + 10, w, lane);
        }
      }
    }
    float* o = p.out + OGP + (size_t)task * 4096;
#pragma unroll
    for (int ni = 0; ni < 4; ++ni)
#pragma unroll
      for (int i = 0; i < 4; ++i) o[(16 * w + 4 * q4 + i) * 64 + ni * 16 + l16] = S[ni][i];
  } else {
    const int k = task - 32;
    const float* s0 = p.state_gdn + (size_t)k * 4096;
#pragma unroll
    for (int ni = 0; ni < 4; ++ni)
#pragma unroll
      for (int i = 0; i < 4; ++i) S[ni][i] = s0[(16 * w + 4 * q4 + i) * 64 + ni * 16 + l16];
    GStage st;
    const int slot = 4096 + k;
    gdn_load(st, gM, gN, slot, w, lane);
    gdn_step(S, st, gS, slot, w, lane, ST0);
    float* o = p.out + OGS + (size_t)k * 4096;
#pragma unroll
    for (int ni = 0; ni < 4; ++ni)
#pragma unroll
      for (int i = 0; i < 4; ++i) o[(16 * w + 4 * q4 + i) * 64 + ni * 16 + l16] = S[ni][i];
  }
}

struct HStage { uint2 dl; float4 dc; };
DI void hg_ld(HStage& st, const u16* hD, const float* hdec, int slot, int el4, int d0) {
  st.dl = *(const uint2*)(hD + (size_t)slot * 16384 + el4 * 4);
  st.dc = *(const float4*)(hdec + (size_t)slot * 128 + d0);
}
DI void hg_st(float (&S)[4], const HStage& st, u16* hD, int slot, int el4) {
  *(uint2*)(hD + (size_t)slot * 16384 + el4 * 4) = make_uint2(pk2(S[0], S[1]), pk2(S[2], S[3]));
  S[0] = st.dc.x * S[0] + __uint_as_float(st.dl.x << 16); S[1] = st.dc.y * S[1] + __uint_as_float(st.dl.x & 0xffff0000u);
  S[2] = st.dc.z * S[2] + __uint_as_float(st.dl.y << 16); S[3] = st.dc.w * S[3] + __uint_as_float(st.dl.y & 0xffff0000u);
}

static __device__ __forceinline__ void hg_scan_wg(const Params& p, int task, char* smem) {
  const int tid = opaque_tid();
  u16* hD = (u16*)(p.ws + WS_HD);
  const float* hdec = (const float*)(p.ws + WS_HDEC);
  float* tile = (float*)smem;
  const int td = tid >> 1, th = tid & 1;
  float S[4];
  float* o;
  const int part = task & 15;
  const int el4 = (part << 8) + tid, d0 = (el4 & 31) * 4, e0 = part * 8, el = tid >> 5;
  __syncthreads();
  if (task < 256) {
    const int bh = task >> 4;
    const int base = bh * 128;
#pragma unroll
    for (int k = 0; k < 4; ++k) S[k] = 0.f;
    HStage st[16];
#pragma unroll
    for (int k = 0; k < 16; ++k) hg_ld(st[k], hD, hdec, base + k, el4, d0);
    for (int c0 = 0; c0 < 128; c0 += 16) {
#pragma unroll
      for (int k = 0; k < 16; ++k) {
        const int c = c0 + k;
        hg_st(S, st[k], hD, base + c, el4);
        if (c + 16 < 128) hg_ld(st[k], hD, hdec, base + c + 16, el4, d0);
      }
    }
    o = p.out + OHP + (size_t)bh * 16384;
  } else {
    const int bh = (task - 256) >> 4;
    const float* s0 = p.state_hgrn + (size_t)bh * 16384;
    HStage st;
    const int slot = 2048 + bh;
    hg_ld(st, hD, hdec, slot, el4, d0);
    {
      float4 v = *(const float4*)(s0 + td * 128 + e0 + th * 4);
      tile[(th * 4 + 0) * 132 + td] = v.x; tile[(th * 4 + 1) * 132 + td] = v.y;
      tile[(th * 4 + 2) * 132 + td] = v.z; tile[(th * 4 + 3) * 132 + td] = v.w;
    }
    __syncthreads();
    {
      float4 v = *(const float4*)(tile + el * 132 + d0);
      S[0] = v.x; S[1] = v.y; S[2] = v.z; S[3] = v.w;
    }
    __syncthreads();
    hg_st(S, st, hD, slot, el4);
    o = p.out + OHS + (size_t)bh * 16384;
  }
  *(float4*)(tile + el * 132 + d0) = make_float4(S[0], S[1], S[2], S[3]);
  __syncthreads();
  {
    float4 v;
    v.x = tile[(th * 4 + 0) * 132 + td]; v.y = tile[(th * 4 + 1) * 132 + td];
    v.z = tile[(th * 4 + 2) * 132 + td]; v.w = tile[(th * 4 + 3) * 132 + td];
    *(float4*)(o + td * 128 + e0 + th * 4) = v;
  }
}

static __device__ __forceinline__ void phase3a(const Params& p, char* smem) {
  const int G = gridDim.x;
  if (G > 64) {
    if (blockIdx.x < 32) gdn_scan_wg(p, blockIdx.x, smem);
    else if (G == 512 && blockIdx.x >= 256 && blockIdx.x < 288) {
    } else {
      HPre pre;
      const int st = G == 512 ? G - 64 : G - 32;
      const int i0 = G == 512 ? (blockIdx.x < 256 ? blockIdx.x - 32 : blockIdx.x - 64) : blockIdx.x - 32;
      if (i0 < NUNIT * 4) hg_prefetch(pre, p, i0 >> 2, i0 & 3, opaque_tid());
      for (int it = i0; it < NUNIT * 4; it += st) { const int nx = it + st; hg_prep(p, it >> 2, it & 3, smem, pre, nx >> 2, nx & 3, nx < NUNIT * 4); }
    }
  } else {
    for (int task = blockIdx.x; task < 32; task += G) gdn_scan_wg(p, task, smem);
    HPre pre;
    if ((int)blockIdx.x < NUNIT * 4) hg_prefetch(pre, p, blockIdx.x >> 2, blockIdx.x & 3, opaque_tid());
    for (int it = blockIdx.x; it < NUNIT * 4; it += G) { const int nx = it + G; hg_prep(p, it >> 2, it & 3, smem, pre, nx >> 2, nx & 3, nx < NUNIT * 4); }
  }
}
static __device__ __forceinline__ void p4_item(const Params& p, int unit, int hh);
static __device__ __forceinline__ void phase3b(const Params& p, char* smem) {
  for (int task = blockIdx.x; task < 256 + 128 + 1024; task += gridDim.x) {
    if (task < 256) hg_scan_wg(p, task, smem);
    else if (task < 384) gdn_scan_wg(p, 32 + task - 256, smem);
    else hg_scan_wg(p, 256 + task - 384, smem);
  }
  for (int it = blockIdx.x; it < 512 * 8; it += gridDim.x) p4_item(p, it >> 3, it & 7);
}

static __device__ __forceinline__ void p4_item(const Params& p, int unit, int hh) {
  const int tid = opaque_tid(), lane = tid & 63, w = tid >> 6, l16 = lane & 15, q4 = lane >> 4;
  u16* P = (u16*)(p.ws + WS_P);
  {
    const bool sample = unit >= 512;
    const int t0 = sample ? T_P + (unit - 512) * 16 : unit * 64;
    if (sample && w > 0) return;
    if (hh < 8) {
      const int slot = slotG(unit, hh);
      const u16* gQ = (const u16*)((char*)p.out + DO_GQ) + (size_t)slot * 4096;
      const u16* gS = (const u16*)(p.ws + WS_GS) + (size_t)slot * 4096;
      const u16* gO = (const u16*)(p.ws + WS_GO) + (size_t)slot * 4096;
      f32x4 acc[4];
      u16 zr[4][4]; float nwr[4];
      {
        const u16* zp = P + (size_t)(t0 + 16 * w + 4 * q4) * NP + PZA + hh * 64 + l16;
#pragma unroll
        for (int ni = 0; ni < 4; ++ni) {
          nwr[ni] = p.gdn_norm_w[16 * ni + l16];
#pragma unroll
          for (int i = 0; i < 4; ++i) zr[ni][i] = zp[(size_t)i * NP + 16 * ni];
        }
      }
#pragma unroll
      for (int ni = 0; ni < 4; ++ni) {
        uint2 ov = *(const uint2*)(gO + ((w * 4 + ni) * 64 + lane) * 4);
        acc[ni][0] = __uint_as_float(ov.x << 16); acc[ni][1] = __uint_as_float(ov.x & 0xffff0000u);
        acc[ni][2] = __uint_as_float(ov.y << 16); acc[ni][3] = __uint_as_float(ov.y & 0xffff0000u);
      }
#pragma unroll
      for (int s = 0; s < 2; ++s) {
        const u16* qa = gQ + (16 * w + l16) * 64 + 32 * s + 4 * q4;
        const uint2 alo = *(const uint2*)(qa), ahi = *(const uint2*)(qa + 16);
        bf16x8 a = __builtin_bit_cast(bf16x8, make_uint4(alo.x, alo.y, ahi.x, ahi.y));
        const u16* sb0 = gS + ((2 * s) * 64 + lane) * 16;
        const u16* sb1 = gS + ((2 * s + 1) * 64 + lane) * 16;
        const uint4 l0 = *(const uint4*)(sb0), l1 = *(const uint4*)(sb0 + 8), h0 = *(const uint4*)(sb1), h1 = *(const uint4*)(sb1 + 8);
        const u32 lo[8] = {l0.x, l0.y, l0.z, l0.w, l1.x, l1.y, l1.z, l1.w};
        const u32 hi[8] = {h0.x, h0.y, h0.z, h0.w, h1.x, h1.y, h1.z, h1.w};
#pragma unroll
        for (int ni = 0; ni < 4; ++ni) {
          bf16x8 b = __builtin_bit_cast(bf16x8, make_uint4(lo[2 * ni], lo[2 * ni + 1], hi[2 * ni], hi[2 * ni + 1]));
          acc[ni] = MFMA(a, b, acc[ni]);
        }
      }
      float ss[4];
#pragma unroll
      for (int i = 0; i < 4; ++i) {
        float s_ = 0.f;
#pragma unroll
        for (int ni = 0; ni < 4; ++ni) s_ += acc[ni][i] * acc[ni][i];
        s_ += __shfl_xor(s_, 1); s_ += __shfl_xor(s_, 2); s_ += __shfl_xor(s_, 4); s_ += __shfl_xor(s_, 8);
        ss[i] = rsqrtf(s_ * (1.f / 64.f) + EPS);
      }
#pragma unroll
      for (int ni = 0; ni < 4; ++ni) {
        const int e = 16 * ni + l16; const float nw = nwr[ni];
#pragma unroll
        for (int i = 0; i < 4; ++i) {
          int tok = t0 + 16 * w + 4 * q4 + i;
          float z = b2f(zr[ni][i]);
          P[(size_t)tok * NP + hh * 64 + e] = f2b(acc[ni][i] * ss[i] * nw * siluf_(z));
        }
      }
    } else {
      const int h = hh - 8, slot = slotH(unit, h);
      const u16* gq = (const u16*)((char*)p.out + DO_HQ) + (size_t)slot * 8192;
      const u16* gOh = (const u16*)((char*)p.out + DO_HO) + (size_t)slot * 8192;
      const u16* hS = (const u16*)(p.ws + WS_HD) + (size_t)slot * 16384;
      f32x4 acc[8];
      u16 zr[8][4]; float nwr[8];
      {
        const u16* zp = P + (size_t)(t0 + 16 * w + 4 * q4) * NP + PZB + h * 128 + l16;
#pragma unroll
        for (int ni = 0; ni < 8; ++ni) {
          nwr[ni] = p.hg_norm_w[16 * ni + l16];
#pragma unroll
          for (int i = 0; i < 4; ++i) zr[ni][i] = zp[(size_t)i * NP + 16 * ni];
        }
      }
#pragma unroll
      for (int ni = 0; ni < 8; ++ni) {
        uint2 ov = *(const uint2*)(gOh + ((w * 8 + ni) * 64 + lane) * 4);
        acc[ni][0] = __uint_as_float(ov.x << 16); acc[ni][1] = __uint_as_float(ov.x & 0xffff0000u);
        acc[ni][2] = __uint_as_float(ov.y << 16); acc[ni][3] = __uint_as_float(ov.y & 0xffff0000u);
      }
#pragma unroll
      for (int s = 0; s < 4; ++s) {
        bf16x8 a = ldfrag(gq, 128, 16 * w, 32 * s, lane);
#pragma unroll
        for (int ni = 0; ni < 8; ++ni) { bf16x8 b = ldfrag(hS, 128, 16 * ni, 32 * s, lane); acc[ni] = MFMA(a, b, acc[ni]); }
      }
      float ss[4];
#pragma unroll
      for (int i = 0; i < 4; ++i) {
        float s_ = 0.f;
#pragma unroll
        for (int ni = 0; ni < 8; ++ni) s_ += acc[ni][i] * acc[ni][i];
        s_ += __shfl_xor(s_, 1); s_ += __shfl_xor(s_, 2); s_ += __shfl_xor(s_, 4); s_ += __shfl_xor(s_, 8);
        ss[i] = rsqrtf(s_ * (1.f / 128.f) + EPS);
      }
#pragma unroll
      for (int ni = 0; ni < 8; ++ni) {
        const int e = 16 * ni + l16; const float nw = nwr[ni];
#pragma unroll
        for (int i = 0; i < 4; ++i) {
          int tok = t0 + 16 * w + 4 * q4 + i;
          float z = b2f(zr[ni][i]);
          P[(size_t)tok * NP + 512 + h * 128 + e] = f2b(acc[ni][i] * ss[i] * nw * siluf_(z));
        }
      }
    }
  }
}

static __device__ __forceinline__ void phase4(const Params& p) {
  for (int it = blockIdx.x; it < NUNIT * 4 + 16 * 8; it += gridDim.x) {
    if (it < NUNIT * 4) p4_item(p, it >> 2, 8 + (it & 3));
    else { const int k = it - NUNIT * 4; p4_item(p, 512 + (k >> 3), k & 7); }
  }
}

static __device__ __forceinline__ void phase5(const Params& p, char* smem) {
  const int tid = opaque_tid(), lane = tid & 63, w = tid >> 6, wm = w >> 1, wn = w & 1, l16 = lane & 15, q4 = lane >> 4;
  const u16* obuf = (const u16*)(p.ws + WS_P);
  const u16* wtout = (const u16*)(p.ws + WS_WOUT);
  u16* ytmp = (u16*)(p.ws + WS_GM);
  u16* stg = (u16*)(smem + 24576);
  float* part = (float*)(p.ws + WS_PART);
  const int G = gridDim.x;
  int x = blockIdx.x & 7, j = blockIdx.x >> 3, nj = (G + 7 - x) / 8, nxcd = 8;
  if (G < 8) { x = blockIdx.x; j = 0; nj = 1; nxcd = G; }
  const int nmt = (128 - x + nxcd - 1) / nxcd;
  bool pre = false;
  for (int li = j; li < nmt * 8; li += nj) {
    const int mt = x + (li >> 3) * nxcd, nt = li & 7;
    const int nli = li + nj; const bool hn = nli < nmt * 8;
    f32x4 acc[8][4];
    gemm_tile(obuf, NP, wtout, mt * 256, nt * 128, 0, 32, smem, acc, pre, hn, (x + (nli >> 3) * nxcd) * 256, (nli & 7) * 128);
    pre = hn;
#pragma unroll
    for (int hh = 0; hh < 2; ++hh) {
      if (wm == hh) {
#pragma unroll
        for (int mi = 0; mi < 8; ++mi)
#pragma unroll
          for (int ni = 0; ni < 4; ++ni)
            *(uint2*)(stg + (mi * 16 + l16) * 136 + wn * 64 + ni * 16 + q4 * 4) = make_uint2(pk2(acc[mi][ni][0], acc[mi][ni][1]), pk2(acc[mi][ni][2], acc[mi][ni][3]));
      }
      EPI_BARRIER();
#pragma unroll
      for (int k = 0; k < 8; ++k) {
        int id = tid + 256 * k, row = id >> 4, cc = id & 15;
        *(u32x4*)(ytmp + (size_t)(mt * 256 + hh * 128 + row) * DM + nt * 128 + cc * 8) = *(const u32x4*)(stg + row * 136 + cc * 8);
      }
      EPI_BARRIER();
    }
  }
  for (int q = blockIdx.x; q < 64; q += G) {
    const int nt = q >> 3, kq = q & 7;
    f32x4 acc[8][4];
    gemm_tile(obuf, NP, wtout, 128 * 256, nt * 128, kq * 128, 4, smem, acc);
    int rb2 = kq * 256 + wm * 128 + l16;
#pragma unroll
    for (int mi = 0; mi < 8; ++mi) {
      asm volatile("" : "+v"(rb2));
      float* pr = part + (size_t)(rb2 + mi * 16) * DM + nt * 128 + wn * 64 + q4 * 4;
#pragma unroll
      for (int ni = 0; ni < 4; ++ni) *(float4*)(pr + ni * 16) = make_float4(acc[mi][ni][0], acc[mi][ni][1], acc[mi][ni][2], acc[mi][ni][3]);
    }
  }
}

static __device__ __forceinline__ void phase6(const Params& p) {
  const int tid = opaque_tid(), lane = tid & 63, w = tid >> 6;
  const u16* ytmp = (const u16*)(p.ws + WS_GM);
  const float* part = (const float*)(p.ws + WS_PART);
  float4 nw[4];
#pragma unroll
  for (int i = 0; i < 4; ++i) nw[i] = *(const float4*)(p.final_norm_w + i * 256 + lane * 4);
  for (int task = blockIdx.x; task < T_P / 16; task += gridDim.x) {
    const int r0 = task * 16 + w * 4;
    {
      float4 v[4][4]; uint2 ow[4][4];
#pragma unroll
      for (int r = 0; r < 4; ++r) {
        const float* xr = p.x_prompt + (size_t)(r0 + r) * DM;
        const u16* yr = ytmp + (size_t)(r0 + r) * DM;
#pragma unroll
        for (int i = 0; i < 4; ++i) { v[r][i] = ldnt4(xr + i * 256 + lane * 4); ow[r][i] = *(const uint2*)(yr + i * 256 + lane * 4); }
      }
#pragma unroll
      for (int r = 0; r < 4; ++r) {
        float s = 0.f;
#pragma unroll
        for (int i = 0; i < 4; ++i) {
          float4 t = v[r][i];
          t.x += __uint_as_float(ow[r][i].x << 16); t.y += __uint_as_float(ow[r][i].x & 0xffff0000u);
          t.z += __uint_as_float(ow[r][i].y << 16); t.w += __uint_as_float(ow[r][i].y & 0xffff0000u);
          v[r][i] = t; s += t.x * t.x + t.y * t.y + t.z * t.z + t.w * t.w;
        }
#pragma unroll
        for (int o = 32; o > 0; o >>= 1) s += __shfl_xor(s, o);
        const float rs = rsqrtf(s * (1.f / DM) + EPS);
        float* yo = p.out + OY + (size_t)(r0 + r) * DM;
#pragma unroll
        for (int i = 0; i < 4; ++i) {
          float4 t = v[r][i];
          t.x *= rs * nw[i].x; t.y *= rs * nw[i].y; t.z *= rs * nw[i].z; t.w *= rs * nw[i].w;
          { f32x4 tv = {t.x, t.y, t.z, t.w}; __builtin_nontemporal_store(tv, (f32x4*)(yo + i * 256 + lane * 4)); }
        }
      }
    }
  }
  {
    const int nwaves = gridDim.x * 4;
    {
#pragma unroll 1
      for (int rl = blockIdx.x * 4 + w; rl < T_ALL - T_P; rl += nwaves) {
        float4 v[4]; float ss = 0.f;
#pragma unroll
        for (int i = 0; i < 4; ++i) {
          float4 t = *(const float4*)(p.x_sample + (size_t)rl * DM + i * 256 + lane * 4);
#pragma unroll
          for (int kq = 0; kq < 8; ++kq) {
            float4 u = *(const float4*)(part + ((size_t)kq * 256 + rl) * DM + i * 256 + lane * 4);
            t.x += u.x; t.y += u.y; t.z += u.z; t.w += u.w;
          }
          v[i] = t; ss += t.x * t.x + t.y * t.y + t.z * t.z + t.w * t.w;
        }
#pragma unroll
        for (int o = 32; o > 0; o >>= 1) ss += __shfl_xor(ss, o);
        const float rs = rsqrtf(ss * (1.f / DM) + EPS);
        float* yr = p.out + OY + (size_t)(T_P + rl) * DM;
#pragma unroll
        for (int i = 0; i < 4; ++i) {
          float4 t = v[i];
          t.x *= rs * nw[i].x; t.y *= rs * nw[i].y; t.z *= rs * nw[i].z; t.w *= rs * nw[i].w;
          *(float4*)(yr + i * 256 + lane * 4) = t;
        }
      }
    }
  }
}

__global__ void __launch_bounds__(256, 2) fwd_megakernel(Params p) {
  __shared__ __attribute__((aligned(16))) char smem[65536];
  cg::grid_group grid = cg::this_grid();
  XcdBarrier xb = xcd_barrier_post((unsigned*)(p.ws + WS_BAR));
  if (p.out == nullptr) grid.sync();
  phase0(p, smem);
  xcd_barrier(xb);
  phase1(p, smem);
  xcd_barrier(xb);
  phase2a(p, smem);
  xcd_barrier(xb);
  phase3a(p, smem);
  xcd_barrier(xb);
  phase3b(p, smem);
  xcd_barrier(xb);
  phase4(p);
  xcd_barrier(xb);
  phase5(p, smem);
  xcd_barrier(xb);
  phase6(p);
}

extern "C" void kernel_launch(void* const* d_in, const int* in_sizes, int n_in, void* d_out, int out_size, void* d_ws, size_t ws_size,
                              hipStream_t stream) {
  static int grid_blocks = 0;
  if (!grid_blocks) {
    int dev = 0, cus = 0, per_cu = 0;
    hipGetDevice(&dev);
    hipDeviceGetAttribute(&cus, hipDeviceAttributeMultiprocessorCount, dev);
    hipOccupancyMaxActiveBlocksPerMultiprocessor(&per_cu, fwd_megakernel, 256, 0);
    if (per_cu > 2) per_cu = 2;
    if (per_cu < 1) per_cu = 1;
    grid_blocks = cus * per_cu;
  }
  if (ws_size < WS_END) { fprintf(stderr, "workspace too small\n"); return; }
  Params p{};
  p.x_prompt = (const float*)d_in[0]; p.x_sample = (const float*)d_in[1]; p.state_conv = (const float*)d_in[2];
  p.state_gdn = (const float*)d_in[3]; p.state_hgrn = (const float*)d_in[4]; p.norm_w = (const float*)d_in[5];
  p.w_in = (const float*)d_in[6]; p.conv_w = (const float*)d_in[7]; p.A_log = (const float*)d_in[8]; p.dt_bias = (const float*)d_in[9];
  p.gdn_norm_w = (const float*)d_in[10]; p.lb_logits = (const float*)d_in[11]; p.hg_norm_w = (const float*)d_in[12];
  p.w_out = (const float*)d_in[13]; p.final_norm_w = (const float*)d_in[14];
  p.out = (float*)d_out; p.ws = (char*)d_ws;
  hipMemsetAsync((char*)d_ws + WS_BAR, 0, 16384, stream);
  void* args[] = {&p};
  hipError_t e = hipLaunchCooperativeKernel((void*)fwd_megakernel, dim3(grid_blocks), dim3(256), args, 0, stream);
  if (e != hipSuccess) fprintf(stderr, "cooperative launch failed: %s (grid %d)\n", hipGetErrorString(e), grid_blocks);
}
```
